# Optimizing an MI355X kernel written in HIP

```python
import jax, jax.numpy as jnp
from jax import lax
import numpy as np

D_MODEL = 1024
BATCH = 8
SEQ = 2048
DEPTH = 1

CHUNK = 64
Q_BLOCK = 2 * CHUNK
D_MIX = D_MODEL
ATTN_HEADS = 8
HEAD_DIM = 64
D_ATTN = ATTN_HEADS * HEAD_DIM
D_CONV = D_MIX - D_ATTN
CONV_WIDTH = 3
N_EXPERTS = 32
TOP_K = 4
D_EXPERT = D_MODEL
SWIGLU_LIMIT = 7.0
SWIGLU_ALPHA = 1.702
MOE_BLOCK = 128
N_MOD = 6
EPS = 1e-6
SPLITS = (D_ATTN, 2 * D_ATTN, 3 * D_ATTN, 3 * D_ATTN + ATTN_HEADS,
          3 * D_ATTN + ATTN_HEADS + D_CONV, 3 * D_ATTN + ATTN_HEADS + 2 * D_CONV)
D_IN_PROJ = 3 * D_ATTN + ATTN_HEADS + 3 * D_CONV

kernel_name = "hybrid_fox_shortconv_moe_adaln"


def rms_norm(x, w):
    xf = x.astype(jnp.float32)
    y = xf * lax.rsqrt(jnp.mean(xf * xf, axis=-1, keepdims=True) + EPS)
    return (y * w.astype(jnp.float32)).astype(x.dtype)


def forgetting_attention(q, k, v, log_f):
    s_len = q.shape[2]
    cum = jnp.cumsum(log_f, axis=-1)
    scale = HEAD_DIM ** -0.5
    outs = []
    for i in range(s_len // Q_BLOCK):
        q0, q1 = i * Q_BLOCK, (i + 1) * Q_BLOCK
        s = jnp.einsum('bhqd,bhkd->bhqk', q[:, :, q0:q1], k[:, :, :q1],
                       preferred_element_type=jnp.float32) * scale
        s = s + cum[:, :, q0:q1, None] - cum[:, :, None, :q1]
        q_pos = q0 + jnp.arange(Q_BLOCK)
        k_pos = jnp.arange(q1)
        s = jnp.where(k_pos[None, :] <= q_pos[:, None], s, -jnp.inf)
        p = jax.nn.softmax(s, axis=-1)
        outs.append(jnp.einsum('bhqk,bhkd->bhqd', p.astype(v.dtype), v[:, :, :q1]))
    return jnp.concatenate(outs, axis=2)


def causal_short_conv(u, w):
    s_len = u.shape[1]
    up = jnp.pad(u, ((0, 0), (CONV_WIDTH - 1, 0), (0, 0)))
    y = w[0] * up[:, 0:s_len]
    for j in range(1, CONV_WIDTH):
        y = y + w[j] * up[:, j:j + s_len]
    return y


def moe_ffn(h, w_router, b_router, w_gate_up, b_gate_up, w_down, b_down):
    bsz, s_len, d = h.shape
    t = bsz * s_len
    hf = h.reshape(t, d)
    logits = jnp.einsum('td,de->te', hf, w_router, preferred_element_type=jnp.float32) \
        + b_router.astype(jnp.float32)
    top_logits, top_idx = lax.top_k(logits, TOP_K)
    top_w = jax.nn.softmax(top_logits, axis=-1)
    n_assign = t * TOP_K
    flat_e = top_idx.reshape(n_assign)
    order = jnp.argsort(flat_e)
    sorted_e = flat_e[order]
    sorted_tok = (order // TOP_K).astype(jnp.int32)
    sorted_w = top_w.reshape(n_assign)[order]
    counts = jnp.bincount(flat_e, length=N_EXPERTS)
    padded = (counts + MOE_BLOCK - 1) // MOE_BLOCK * MOE_BLOCK
    pad_end = jnp.cumsum(padded)
    pad_start = pad_end - padded
    start = jnp.cumsum(counts) - counts
    dest = pad_start[sorted_e] + (jnp.arange(n_assign) - start[sorted_e])
    n_blocks = -(-n_assign // MOE_BLOCK) + N_EXPERTS
    n_rows = n_blocks * MOE_BLOCK
    row_tok = jnp.zeros((n_rows,), jnp.int32).at[dest].set(sorted_tok)
    row_w = jnp.zeros((n_rows,), jnp.float32).at[dest].set(sorted_w)
    block_e = jnp.minimum(
        jnp.searchsorted(pad_end, jnp.arange(n_blocks) * MOE_BLOCK, side='right'), N_EXPERTS - 1)
    xb = hf[row_tok].reshape(n_blocks, MOE_BLOCK, d)

    def expert_block(args):
        xe, e = args
        gu = xe @ w_gate_up[e] + b_gate_up[e]
        gate, up = jnp.split(gu, 2, axis=-1)
        gate = jnp.minimum(gate, SWIGLU_LIMIT)
        up = jnp.clip(up, -SWIGLU_LIMIT, SWIGLU_LIMIT)
        act = gate * jax.nn.sigmoid(SWIGLU_ALPHA * gate) * (up + 1)
        return act @ w_down[e] + b_down[e]

    yb = lax.map(expert_block, (xb, block_e))
    y_rows = yb.reshape(n_rows, d) * row_w[:, None].astype(yb.dtype)
    return jnp.zeros_like(hf).at[row_tok].add(y_rows).reshape(bsz, s_len, d)


def setup_inputs(seed: int = 0) -> dict:
    key = jax.random.key(seed)
    ks = jax.random.split(key, 20)
    L, D = DEPTH, D_MODEL
    nrm = jax.random.normal
    return {
        "x": nrm(ks[0], (BATCH, SEQ, D), jnp.float32),
        "c": nrm(ks[1], (BATCH, D), jnp.float32),
        "w_ada": nrm(ks[2], (L, D, N_MOD * D), jnp.float32) * (0.5 * D ** -0.5),
        "b_ada": nrm(ks[3], (L, N_MOD * D), jnp.float32) * 0.01,
        "norm1_w": 1.0 + 0.1 * nrm(ks[4], (L, D), jnp.float32),
        "w_in": nrm(ks[5], (L, D, D_IN_PROJ), jnp.float32) * D ** -0.5,
        "b_forget": 3.0 + 0.5 * nrm(ks[6], (L, ATTN_HEADS), jnp.float32),
        "q_norm_w": 1.0 + 0.1 * nrm(ks[7], (L, HEAD_DIM), jnp.float32),
        "k_norm_w": 1.0 + 0.1 * nrm(ks[8], (L, HEAD_DIM), jnp.float32),
        "conv_w": nrm(ks[9], (L, CONV_WIDTH, D_CONV), jnp.float32) * CONV_WIDTH ** -0.5,
        "attn_out_norm_w": 1.0 + 0.1 * nrm(ks[10], (L, D_ATTN), jnp.float32),
        "conv_out_norm_w": 1.0 + 0.1 * nrm(ks[11], (L, D_CONV), jnp.float32),
        "w_out": nrm(ks[12], (L, D_MIX, D), jnp.float32) * D_MIX ** -0.5,
        "norm2_w": 1.0 + 0.1 * nrm(ks[13], (L, D), jnp.float32),
        "w_router": nrm(ks[14], (L, D, N_EXPERTS), jnp.float32) * D ** -0.5,
        "b_router": nrm(ks[15], (L, N_EXPERTS), jnp.float32) * 0.01,
        "w_gate_up": nrm(ks[16], (L, N_EXPERTS, D, 2 * D_EXPERT), jnp.float32) * D ** -0.5,
        "b_gate_up": nrm(ks[17], (L, N_EXPERTS, 2 * D_EXPERT), jnp.float32) * 0.01,
        "w_down": nrm(ks[18], (L, N_EXPERTS, D_EXPERT, D), jnp.float32) * D_EXPERT ** -0.5,
        "b_down": nrm(ks[19], (L, N_EXPERTS, D), jnp.float32) * 0.01,
    }


def reference(x, c, w_ada, b_ada, norm1_w, w_in, b_forget, q_norm_w, k_norm_w, conv_w,
              attn_out_norm_w, conv_out_norm_w, w_out, norm2_w, w_router, b_router,
              w_gate_up, b_gate_up, w_down, b_down):
    bsz, s_len, _ = x.shape

    def to_heads(t):
        return t.reshape(bsz, s_len, ATTN_HEADS, HEAD_DIM).transpose(0, 2, 1, 3)

    for l in range(DEPTH):
        mod = jnp.einsum('bd,de->be', jax.nn.silu(c), w_ada[l]) + b_ada[l]
        sh1, sc1, g1, sh2, sc2, g2 = jnp.split(mod[:, None, :], N_MOD, axis=-1)

        h = rms_norm(x, norm1_w[l]) * (1 + sc1) + sh1
        proj = h @ w_in[l]
        q, k, v, f_logit, gb, gc, u = jnp.split(proj, SPLITS, axis=-1)

        qh = rms_norm(to_heads(q), q_norm_w[l])
        kh = rms_norm(to_heads(k), k_norm_w[l])
        vh = to_heads(v)
        log_f = jax.nn.log_sigmoid((f_logit + b_forget[l]).astype(jnp.float32)).transpose(0, 2, 1)
        attn = forgetting_attention(qh, kh, vh, log_f)
        attn = attn.transpose(0, 2, 1, 3).reshape(bsz, s_len, D_ATTN)

        conv = gb * causal_short_conv(gc * u, conv_w[l])

        mixed = jnp.concatenate([rms_norm(attn, attn_out_norm_w[l]),
                                 rms_norm(conv, conv_out_norm_w[l])], axis=-1)
        x = x + g1 * (mixed @ w_out[l])

        h2 = rms_norm(x, norm2_w[l]) * (1 + sc2) + sh2
        x = x + g2 * moe_ffn(h2, w_router[l], b_router[l], w_gate_up[l], b_gate_up[l],
                             w_down[l], b_down[l])
    return x
```

```cpp
#include <hip/hip_runtime.h>
#include <cstdint>
#include <cstdio>


#define GAS __attribute__((address_space(1)))
#define LAS __attribute__((address_space(3)))
typedef unsigned short bf16;
typedef short bf16x8 __attribute__((ext_vector_type(8)));
typedef float f32x4 __attribute__((ext_vector_type(4)));
typedef float f32x2 __attribute__((ext_vector_type(2)));
typedef unsigned u32x4 __attribute__((ext_vector_type(4)));
typedef unsigned u32x2 __attribute__((ext_vector_type(2)));
typedef __bf16 bf16x2_t __attribute__((ext_vector_type(2)));

constexpr int NB = 8, SEQ = 2048, DM = 1024, T = NB * SEQ;
constexpr int DA = 512, DC = 512, NH = 8, HD = 64;
constexpr int NE = 32, TOPK = 4, DE = 1024;
constexpr int NIN = 3080, NMOD = 6 * DM;
constexpr int COL_F = 1536, COL_GB = 1544, COL_GC = 2056, COL_U = 2568;
constexpr float EPS = 1e-6f, LOG2E = 1.4426950408889634f;
constexpr float C2 = 0.125f * LOG2E;
constexpr int NWAVES = 8, NTHR = 512;
constexpr int ECAP = T;
constexpr int MAXMT = T * TOPK / 256 + NE;

constexpr size_t MiB = 1u << 20;
constexpr size_t WS_CTL = 0, CTL_ZERO_BYTES = 1 * MiB;
constexpr size_t WS_MODP = 1 * MiB;
constexpr size_t WS_LC = 2 * MiB;
constexpr size_t WS_TOT = WS_LC + 512 * 1024;
constexpr size_t WS_MODF = 3 * MiB;
constexpr size_t WS_WFC = 3 * MiB + 512 * 1024;
constexpr size_t WS_WRA = 12 * MiB;
constexpr size_t WS_CSTP = 13 * MiB;
constexpr size_t WS_WIN = 4 * MiB;
constexpr size_t WS_WOUT = 10 * MiB;
constexpr size_t WS_WGU = 16 * MiB;
constexpr size_t WS_WD = 144 * MiB;
constexpr size_t WS_H = 208 * MiB;
constexpr size_t WS_Q = 240 * MiB, WS_K = 256 * MiB, WS_V = 272 * MiB;
constexpr size_t WS_GB = 288 * MiB, WS_CU = 304 * MiB;
constexpr size_t WS_MIX = 320 * MiB;
constexpr size_t WS_TOKSLOT = 352 * MiB;
constexpr size_t WS_ROWTOK = 353 * MiB;
constexpr size_t WS_ROWW = 356 * MiB;
constexpr size_t WS_ACT = 360 * MiB;
constexpr size_t WS_Y = 504 * MiB;
constexpr size_t WS_O = 648 * MiB;
constexpr size_t WS_END = 664 * MiB;
constexpr int CW_BAR = 4096;
constexpr int CW_CNT = 16384;

constexpr int LDS_BYTES = 147456;
constexpr int MISC_OFF = LDS_BYTES - 512;

#define LDS_WAIT() asm volatile("s_waitcnt lgkmcnt(0)" ::: "memory")
#define VM_WAIT() asm volatile("s_waitcnt vmcnt(0)" ::: "memory")

__device__ __forceinline__ unsigned cvtpk(float lo, float hi) { f32x2 v = {lo, hi}; bf16x2_t b = __builtin_convertvector(v, bf16x2_t); return __builtin_bit_cast(unsigned, b); }
__device__ __forceinline__ float bf_lo(unsigned w) { return __uint_as_float(w << 16); }
__device__ __forceinline__ float bf_hi(unsigned w) { return __uint_as_float(w & 0xffff0000u); }

#define XB_TMO      128
#define XB_XCNT(j)  (256  + 64 * (j))
#define XB_XSUB(j)  (1280 + 64 * (j))
#define XB_XGEN(j)  (2304 + 64 * (j))
#define XB_TOP      3328
#define XB_TOPGEN   3392
#define XCD_BAR_WORDS 3456
#define XB_SPIN_CAP (1u << 18)

__device__ __forceinline__ unsigned xb_ld(unsigned* p)              { return __hip_atomic_load(p, __ATOMIC_RELAXED, __HIP_MEMORY_SCOPE_AGENT); }
__device__ __forceinline__ unsigned xb_add(unsigned* p, unsigned v) { return __hip_atomic_fetch_add(p, v, __ATOMIC_RELAXED, __HIP_MEMORY_SCOPE_AGENT); }
__device__ __forceinline__ unsigned xb_xcc_id() { return (unsigned)__builtin_amdgcn_s_getreg((3 << 11) | 20) & 0xFu; }
#define XB_SPIN(cond, bar) do { unsigned _sp = 0; while (cond) { __builtin_amdgcn_s_sleep(1); \
    if ((++_sp & 255u) == 0u) { if (xb_ld(&(bar)[XB_TMO])) break; if (_sp > XB_SPIN_CAP) { atomicAdd(&(bar)[XB_TMO], 1u); break; } } } } while (0)

struct XcdBarrier { unsigned* bar; unsigned x; volatile LAS unsigned* st; };

__device__ __forceinline__ XcdBarrier xcd_barrier_post(unsigned* bar, volatile LAS unsigned* st) {
    XcdBarrier b; b.bar = bar; b.x = xb_xcc_id(); b.st = st;
    if (threadIdx.x == 0) (void)xb_add(&bar[XB_XCNT(b.x)], 1u);
    return b;
}
__device__ __forceinline__ void xcd_barrier_complete(unsigned* bar, unsigned x, unsigned& nloc, unsigned& nx) {
    const unsigned G = gridDim.x * gridDim.y * gridDim.z;
    unsigned sum, cnt, mine, sp = 0u;
    for (;;) {
        sum = 0u; cnt = 0u; mine = 0u;
#pragma unroll
        for (unsigned j = 0; j < 16; ++j) { const unsigned c = xb_ld(&bar[XB_XCNT(j)]); sum += c; cnt += (c > 0u) ? 1u : 0u; mine = (j == x) ? c : mine; }
        if (sum == G) break;
        __builtin_amdgcn_s_sleep(1);
        if ((++sp & 255u) == 0u) { if (xb_ld(&bar[XB_TMO])) break; if (sp > XB_SPIN_CAP) { atomicAdd(&bar[XB_TMO], 1u); break; } }
    }
    nloc = mine > 0u ? mine : 1u; nx = cnt > 0u ? cnt : 1u;
}
__device__ __forceinline__ void xcd_barrier(const XcdBarrier& b) {
    asm volatile("s_waitcnt vmcnt(0)" ::: "memory");
    __syncthreads();
    if (threadIdx.x == 0) {
        unsigned* bar = b.bar;
        __builtin_amdgcn_s_waitcnt(0);
        unsigned nloc = b.st[0], nx = b.st[1];
        if (nloc == 0u) { xcd_barrier_complete(bar, b.x, nloc, nx); b.st[0] = nloc; b.st[1] = nx; }
        const unsigned old = xb_add(&bar[XB_XSUB(b.x)], 1u);
        const unsigned gen = old / nloc;
        if (old + 1u == (gen + 1u) * nloc) {
            __builtin_amdgcn_fence(__ATOMIC_RELEASE, "agent");
            asm volatile("s_waitcnt vmcnt(0)" ::: "memory");
            const unsigned og = xb_add(&bar[XB_TOP], 1u);
            const unsigned tg = og / nx;
            if (og + 1u == (tg + 1u) * nx) xb_add(&bar[XB_TOPGEN], 1u);
            else XB_SPIN(xb_ld(&bar[XB_TOPGEN]) == tg, bar);
            __builtin_amdgcn_fence(__ATOMIC_ACQUIRE, "agent");
            xb_add(&bar[XB_XGEN(b.x)], 1u);
            asm volatile("s_waitcnt vmcnt(0)" ::: "memory");
        } else {
            XB_SPIN(xb_ld(&bar[XB_XGEN(b.x)]) == gen, bar);
            __builtin_amdgcn_fence(__ATOMIC_ACQUIRE, "agent");
            asm volatile("s_waitcnt vmcnt(0)" ::: "memory");
        }
    }
    __syncthreads();
}

__device__ __forceinline__ void store16_wt(void* p, u32x4 v) { asm volatile("global_store_dwordx4 %0, %1, off sc1\n\ts_nop 1" :: "v"(p), "v"(v) : "memory"); }
__device__ __forceinline__ int opaque_tid() { int t = threadIdx.x; asm volatile("" : "+v"(t)); return t; }
__device__ __forceinline__ float wave_sum(float v) {
#pragma unroll
    for (int o = 1; o < 64; o <<= 1) v += __shfl_xor(v, o);
    return v;
}
__device__ __forceinline__ float siluf(float v) { return v / (1.f + __expf(-v)); }

struct Args {
    const float* x; const float* c; const float* w_ada; const float* b_ada; const float* norm1_w; const float* w_in; const float* b_forget;
    const float* q_norm_w; const float* k_norm_w; const float* conv_w; const float* attn_out_norm_w; const float* conv_out_norm_w; const float* w_out;
    const float* norm2_w; const float* w_router; const float* b_router; const float* w_gate_up; const float* b_gate_up; const float* w_down; const float* b_down;
    float* out; unsigned char* ws;
};

struct TItem { const float* src; bf16* dst; int ldw, K; };
__device__ __forceinline__ void titem_load(const TItem& t, int lane, f32x4 (&v)[8]) {
#pragma unroll
    for (int i = 0; i < 8; ++i) v[i] = __builtin_nontemporal_load((const f32x4*)(t.src + (size_t)(16 * (i >> 1) + 2 * (lane >> 3) + (i & 1)) * t.ldw + 4 * (lane & 7)));
}
__device__ __forceinline__ void titem_store(const TItem& t, int lane, const f32x4 (&v)[8], LAS unsigned* scr) {
#pragma unroll
    for (int ip = 0; ip < 4; ++ip) { const int kp = 8 * ip + (lane >> 3);
#pragma unroll
        for (int j = 0; j < 4; ++j) scr[(4 * (lane & 7) + j) * 33 + kp] = cvtpk(v[2 * ip][j], v[2 * ip + 1][j]); }
    LDS_WAIT(); asm volatile("" ::: "memory");
#pragma unroll
    for (int p = 0; p < 4; ++p) { const int n = (lane >> 3) + 8 * p, c = lane & 7; const LAS unsigned* s = scr + n * 33 + 4 * c;
        u32x4 o; o.x = s[0]; o.y = s[1]; o.z = s[2]; o.w = s[3];
        *(u32x4*)(t.dst + (size_t)n * t.K + 8 * c) = o; }
    LDS_WAIT(); asm volatile("" ::: "memory");
}

constexpr float YSCALE = 32.f;
constexpr float WSCALE = 64.f;
typedef int v8i __attribute__((ext_vector_type(8)));
__device__ __forceinline__ unsigned pack4_fp8(float a, float b, float c, float d) { unsigned w = __builtin_amdgcn_cvt_pk_fp8_f32(a, b, 0u, false); return __builtin_amdgcn_cvt_pk_fp8_f32(c, d, w, true); }
struct TItem8 { const float* src; unsigned char* dst; int ldw, K; };
__device__ __forceinline__ void titem8_load(const TItem8& t, int lane, f32x4 (&v)[16]) {
#pragma unroll
    for (int i = 0; i < 16; ++i) v[i] = __builtin_nontemporal_load((const f32x4*)(t.src + (size_t)(32 * (i >> 2) + 4 * (lane >> 3) + (i & 3)) * t.ldw + 4 * (lane & 7)));
}
__device__ __forceinline__ void titem8_store(const TItem8& t, int lane, const f32x4 (&v)[16], LAS unsigned* scr) {
#pragma unroll
    for (int q = 0; q < 4; ++q) { const int kq = 8 * q + (lane >> 3);
#pragma unroll
        for (int j = 0; j < 4; ++j) scr[(4 * (lane & 7) + j) * 33 + kq] = pack4_fp8(v[4 * q][j] * WSCALE, v[4 * q + 1][j] * WSCALE, v[4 * q + 2][j] * WSCALE, v[4 * q + 3][j] * WSCALE); }
    LDS_WAIT(); asm volatile("" ::: "memory");
#pragma unroll
    for (int p = 0; p < 4; ++p) { const int n = (lane >> 3) + 8 * p, c = lane & 7; const LAS unsigned* s = scr + n * 33 + 4 * c;
        u32x4 o; o.x = s[0]; o.y = s[1]; o.z = s[2]; o.w = s[3];
        __builtin_nontemporal_store(o, (u32x4*)(t.dst + (size_t)n * t.K + 16 * c)); }
    LDS_WAIT(); asm volatile("" ::: "memory");
}

__device__ __forceinline__ int win_src_col(int g) {
    const int pn = g >> 3, p0 = (g & 7) * 32, bj = p0 >> 7, wc = (p0 >> 5) & 3;
    if (pn < 2) return 256 * pn + 64 * wc + 32 * bj;
    if (pn < 4) return 512 + 256 * (pn - 2) + 64 * wc + 32 * bj;
    if (pn < 6) return 1024 + 256 * (pn - 4) + p0;
    if (pn < 8) return COL_GB + 256 * (pn - 6) + p0;
    return (bj ? COL_U : COL_GC) + 128 * (pn - 8) + 32 * wc;
}

namespace pg8 {
constexpr int BM = 256, BK = 64, HALF = 128, HTB = HALF * BK * 2, STAGE_BYTES = 8 * HTB;
__device__ __forceinline__ int lds_byte(int r, int c) { const int st = (r >> 4) * 2 + (c >> 5), rr = r & 15, cc = c & 31, ob = rr * 64 + cc * 2; return st * 1024 + (ob ^ (((ob >> 9) & 1) << 5)); }
__device__ __forceinline__ void stage_rc(int b, int& R, int& C) { const int st = b / 1024, sb = b % 1024, swz = sb ^ (((sb >> 9) & 1) << 5); R = (st >> 1) * 16 + swz / 64; C = (st & 1) * 32 + (swz % 64) / 2; }
__device__ __forceinline__ int perm32(int rho) { const int n = rho >> 4, i = rho & 15; return 8 * (i >> 2) + 4 * n + (i & 3); }
}
struct Unit { int pm, pn; };

template <class Epi, class Sched, bool ALIGN_EPI>
__device__ __forceinline__ void gemm_phase(LAS unsigned char* lds, const bf16* A, const bf16* Bt, const int K, const Sched& S, const Epi& E) {
    using namespace pg8;
    const int tid = opaque_tid(), wid = __builtin_amdgcn_readfirstlane(tid >> 6), lane = tid & 63, wr = wid >> 2, wc = wid & 3, fr = lane & 15, fq = lane >> 4;
    const int nt = K / BK;
    int Ra[2]; unsigned Ca2[2], voffB[2];
#pragma unroll
    for (int i = 0; i < 2; ++i) { int R, C; stage_rc(tid * 16 + i * 8192, R, C); const int Rb = (R & ~31) + perm32(R & 31); Ra[i] = R; Ca2[i] = (unsigned)C * 2u; voffB[i] = (unsigned)(Rb * K + C) * 2u; }
    const size_t kstep = (size_t)(BK * 2), hstep = (size_t)HALF * K * 2, tstep = 2 * hstep;
    const unsigned ldsw = (unsigned)wid * 1024u;
    LAS unsigned char* ldsA = lds + lds_byte(wr * 64 + fr, fq * 8); LAS unsigned char* ldsB = lds + 4 * HTB + lds_byte(wc * 32 + fr, fq * 8);
    asm volatile("" : "+v"(ldsA)); asm volatile("" : "+v"(ldsB));
#define PG8_SA(b, h) (((b) * 2 + (h)) * HTB)
#define PG8_SB(b, h) ((4 + (b) * 2 + (h)) * HTB)
#define PG8_STAGE_B(bufoff, gbase) do { _Pragma("unroll") for (int _i = 0; _i < 2; ++_i) \
        __builtin_amdgcn_global_load_lds((const unsigned*)((const char*)(gbase) + voffB[_i]), (LAS unsigned*)(lds + (bufoff) + ldsw + _i * 8192), 16, 0, 0); } while (0)
#define PG8_STAGE_A(bufoff, kbytes, off, h) do { _Pragma("unroll") for (int _i = 0; _i < 2; ++_i) \
        __builtin_amdgcn_global_load_lds((const unsigned*)((const char*)A + (kbytes) + off[h][_i]), (LAS unsigned*)(lds + (bufoff) + ldsw + _i * 8192), 16, 0, 0); } while (0)
#define PG8_LDA(dst, b, h) do { _Pragma("unroll") for (int m = 0; m < 4; ++m) _Pragma("unroll") for (int k = 0; k < 2; ++k) dst[m][k] = *(const LAS bf16x8*)(ldsA + PG8_SA(b, h) + m * 2048 + k * 1024); } while (0)
#define PG8_LDB(dst, b, h) do { _Pragma("unroll") for (int n = 0; n < 2; ++n) _Pragma("unroll") for (int k = 0; k < 2; ++k) dst[n][k] = *(const LAS bf16x8*)(ldsB + PG8_SA(b, h) + n * 2048 + k * 1024); } while (0)
#define PG8_MMA(ai, bj, At, Bt_) do { __builtin_amdgcn_s_setprio(1); _Pragma("unroll") for (int m = 0; m < 4; ++m) _Pragma("unroll") for (int n = 0; n < 2; ++n) _Pragma("unroll") for (int k = 0; k < 2; ++k) \
        acc[ai][bj][m][n] = __builtin_amdgcn_mfma_f32_16x16x32_bf16(Bt_[n][k], At[m][k], acc[ai][bj][m][n], 0, 0, 0); __builtin_amdgcn_s_setprio(0); } while (0)
#define PG8_WAIT_V(n) asm volatile("s_waitcnt vmcnt(" #n ")" ::: "memory")
#define PG8_WAIT_L(n) asm volatile("s_waitcnt lgkmcnt(" #n ")" ::: "memory")
#define PG8_BAR __builtin_amdgcn_s_barrier()
#define PG8_SCHED __builtin_amdgcn_sched_barrier(0)
    Unit cur, nxt; int ui = 0;
    if (!S.next(0, cur)) return;
    f32x4 acc[2][2][4][2];
#pragma unroll
    for (int a = 0; a < 2; ++a)
#pragma unroll
        for (int b = 0; b < 2; ++b)
#pragma unroll
            for (int m = 0; m < 4; ++m)
#pragma unroll
                for (int n = 0; n < 2; ++n) acc[a][b][m][n] = (f32x4){0.f, 0.f, 0.f, 0.f};
    bf16x8 At[4][2], B0[2][2], B1[2][2];
    LAS float* epi = (LAS float*)(lds + 136192 + wid * 768);
    unsigned coff[2][2], noff[2][2];
#pragma unroll
    for (int h = 0; h < 2; ++h)
#pragma unroll
        for (int i = 0; i < 2; ++i) coff[h][i] = S.a_off(0, cur, HALF * h + Ra[i]) + Ca2[i];
    const char* cB = (const char*)Bt + (size_t)cur.pn * tstep;
    PG8_STAGE_B(PG8_SB(0, 0), cB); PG8_STAGE_B(PG8_SB(0, 1), cB + hstep); PG8_STAGE_A(PG8_SA(0, 0), 0, coff, 0); PG8_STAGE_A(PG8_SA(0, 1), 0, coff, 1);
    if (wr == 1) PG8_BAR;
    PG8_WAIT_V(2); PG8_BAR;
    PG8_STAGE_B(PG8_SB(1, 0), cB + kstep); PG8_STAGE_A(PG8_SA(1, 0), kstep, coff, 0); PG8_STAGE_B(PG8_SB(1, 1), cB + hstep + kstep);
    PG8_WAIT_V(6); PG8_BAR;
    for (;;) {
        const bool has_next = S.next(ui + 1, nxt);
#pragma unroll
        for (int h = 0; h < 2; ++h)
#pragma unroll
            for (int i = 0; i < 2; ++i) noff[h][i] = has_next ? (S.a_off(ui + 1, nxt, HALF * h + Ra[i]) + Ca2[i]) : coff[h][i];
        const char* nB = has_next ? (const char*)Bt + (size_t)nxt.pn * tstep : cB;
#pragma unroll 1
        for (int t = 0; t < nt; t += 2) {
            const bool last = (t == nt - 2);
            const size_t k1 = (size_t)(t + 1) * kstep;
            const size_t k2 = last ? 0 : (size_t)(t + 2) * kstep, k3 = k2 + kstep;
            const char* b2 = last ? nB : cB + (size_t)(t + 2) * kstep; const char* b3 = b2 + kstep;
            unsigned o2[2][2];
#pragma unroll
            for (int h = 0; h < 2; ++h)
#pragma unroll
                for (int i = 0; i < 2; ++i) o2[h][i] = last ? noff[h][i] : coff[h][i];
            if (last) E.prefetch(cur, wr, wc, lane, epi);
            PG8_LDB(B0, 0, 0); PG8_LDB(B1, 0, 1); PG8_SCHED; PG8_LDA(At, 0, 0); PG8_STAGE_A(PG8_SA(1, 1), k1, coff, 1);
            PG8_WAIT_V(8); PG8_WAIT_L(0); PG8_BAR; PG8_MMA(0, 0, At, B0); PG8_MMA(0, 1, At, B1); PG8_BAR; PG8_SCHED;
            PG8_LDA(At, 0, 1); PG8_STAGE_B(PG8_SB(0, 0), b2); PG8_STAGE_B(PG8_SB(0, 1), b2 + hstep); PG8_STAGE_A(PG8_SA(0, 0), k2, o2, 0);
            PG8_WAIT_V(8); PG8_WAIT_L(0); PG8_BAR; PG8_MMA(1, 0, At, B0); PG8_MMA(1, 1, At, B1); PG8_BAR; PG8_SCHED;
            PG8_LDB(B0, 1, 0); PG8_LDB(B1, 1, 1); PG8_SCHED; PG8_LDA(At, 1, 0); PG8_STAGE_A(PG8_SA(0, 1), k2, o2, 1);
            PG8_WAIT_V(8); PG8_WAIT_L(0); PG8_BAR; PG8_MMA(0, 0, At, B0); PG8_MMA(0, 1, At, B1); PG8_BAR; PG8_SCHED;
            PG8_LDA(At, 1, 1); PG8_STAGE_B(PG8_SB(1, 0), b3); PG8_STAGE_B(PG8_SB(1, 1), b3 + hstep); PG8_STAGE_A(PG8_SA(1, 0), k3, o2, 0);
            PG8_WAIT_V(8); PG8_WAIT_L(0); PG8_BAR; PG8_MMA(1, 0, At, B0); PG8_MMA(1, 1, At, B1); PG8_BAR; PG8_SCHED;
        }
        if constexpr (ALIGN_EPI) { if (wr == 0) PG8_BAR; }
        E(acc, cur, wr, wc, fr, fq, (const LAS float*)epi);
        if (!has_next) break;
#pragma unroll
        for (int a = 0; a < 2; ++a)
#pragma unroll
            for (int b = 0; b < 2; ++b)
#pragma unroll
                for (int m = 0; m < 4; ++m)
#pragma unroll
                    for (int n = 0; n < 2; ++n) acc[a][b][m][n] = (f32x4){0.f, 0.f, 0.f, 0.f};
        cur = nxt; cB = nB; ++ui;
#pragma unroll
        for (int h = 0; h < 2; ++h)
#pragma unroll
            for (int i = 0; i < 2; ++i) coff[h][i] = noff[h][i];
        if constexpr (ALIGN_EPI) { if (wr == 1) PG8_BAR; }
    }
    PG8_WAIT_V(0);
    if constexpr (!ALIGN_EPI) { if (wr == 0) PG8_BAR; }
    PG8_BAR;
#undef PG8_SA
#undef PG8_SB
#undef PG8_STAGE_A
#undef PG8_STAGE_B
#undef PG8_LDA
#undef PG8_LDB
#undef PG8_MMA
#undef PG8_WAIT_V
#undef PG8_WAIT_L
#undef PG8_BAR
#undef PG8_SCHED
}

template <class Epi, class Sched, bool ALIGN_EPI>
__device__ __forceinline__ void gemm_phase_f8(LAS unsigned char* lds, const unsigned char* A, const unsigned char* Bt, const int K, const Sched& S, const Epi& E) {
    using namespace pg8;
    const int tid = opaque_tid(), wid = __builtin_amdgcn_readfirstlane(tid >> 6), lane = tid & 63, wr = wid >> 2, wc = wid & 3, fr = lane & 15, fq = lane >> 4;
    const int nt = K / 128;
    const __amdgpu_buffer_rsrc_t rsA = __builtin_amdgcn_make_buffer_rsrc((void*)A, 0, 0x7fffffff, 0x00020000), rsB = __builtin_amdgcn_make_buffer_rsrc((void*)Bt, 0, 0x7fffffff, 0x00020000);
    int Ra[2]; unsigned Ca2[2], voffB[2];
#pragma unroll
    for (int i = 0; i < 2; ++i) { const int p = wid + 8 * i, R = 16 * (p >> 1) + fr, C = 64 * (p & 1) + 16 * fq; const int Rb = (R & ~31) + perm32(R & 31); Ra[i] = R; Ca2[i] = (unsigned)C; voffB[i] = (unsigned)(Rb * K + C); }
    const unsigned kstep = 128, hstep = (unsigned)HALF * K, tstep = 2 * hstep;
    const unsigned ldsw = (unsigned)wid * 1024u;
    LAS unsigned char* ldsA = lds + wr * 8192 + lane * 16; LAS unsigned char* ldsB = lds + 4 * HTB + wc * 4096 + lane * 16;
    asm volatile("" : "+v"(ldsA)); asm volatile("" : "+v"(ldsB));
#define PG8_SA(b, h) (((b) * 2 + (h)) * HTB)
#define PG8_SB(b, h) ((4 + (b) * 2 + (h)) * HTB)
#define PG8_STAGE_B(bufoff, soff) do { _Pragma("unroll") for (int _i = 0; _i < 2; ++_i) \
        __builtin_amdgcn_raw_ptr_buffer_load_lds(rsB, (LAS unsigned*)(lds + (bufoff) + ldsw + _i * 8192), 16, voffB[_i], (soff), 0, 0); } while (0)
#define PG8_STAGE_A(bufoff, soff, h) do { _Pragma("unroll") for (int _i = 0; _i < 2; ++_i) \
        __builtin_amdgcn_raw_ptr_buffer_load_lds(rsA, (LAS unsigned*)(lds + (bufoff) + ldsw + _i * 8192), 16, coff[h][_i], (soff), 0, 0); } while (0)
#define PG8_LD32(dst, ptr) do { const u32x4 lo_ = *(const LAS u32x4*)(ptr), hi_ = *(const LAS u32x4*)((ptr) + 1024); dst = (v8i){(int)lo_.x, (int)lo_.y, (int)lo_.z, (int)lo_.w, (int)hi_.x, (int)hi_.y, (int)hi_.z, (int)hi_.w}; } while (0)
#define PG8_LDA(dst, b, h) do { _Pragma("unroll") for (int m = 0; m < 4; ++m) PG8_LD32(dst[m], ldsA + PG8_SA(b, h) + m * 2048); } while (0)
#define PG8_LDB(dst, b, h) do { _Pragma("unroll") for (int n = 0; n < 2; ++n) PG8_LD32(dst[n], ldsB + PG8_SA(b, h) + n * 2048); } while (0)
#define PG8_MMA(ai, bj, At, Bt_) do { __builtin_amdgcn_s_setprio(1); _Pragma("unroll") for (int m = 0; m < 4; ++m) _Pragma("unroll") for (int n = 0; n < 2; ++n) \
        acc[ai][bj][m][n] = __builtin_amdgcn_mfma_scale_f32_16x16x128_f8f6f4(Bt_[n], At[m], acc[ai][bj][m][n], 0, 0, 0, 0, 0, 0); __builtin_amdgcn_s_setprio(0); } while (0)
#define PG8_WAIT_V(n) asm volatile("s_waitcnt vmcnt(" #n ")" ::: "memory")
#define PG8_WAIT_L(n) asm volatile("s_waitcnt lgkmcnt(" #n ")" ::: "memory")
#define PG8_BAR __builtin_amdgcn_s_barrier()
#define PG8_SCHED __builtin_amdgcn_sched_barrier(0)
    Unit cur, nxt; int ui = 0;
    if (!S.next(0, cur)) return;
    f32x4 acc[2][2][4][2];
#pragma unroll
    for (int a = 0; a < 2; ++a)
#pragma unroll
        for (int b = 0; b < 2; ++b)
#pragma unroll
            for (int m = 0; m < 4; ++m)
#pragma unroll
                for (int n = 0; n < 2; ++n) acc[a][b][m][n] = (f32x4){0.f, 0.f, 0.f, 0.f};
    v8i At[4], B0[2], B1[2];
    LAS float* epi = (LAS float*)(lds + 136192 + wid * 768);
    unsigned coff[2][2];
#pragma unroll
    for (int h = 0; h < 2; ++h)
#pragma unroll
        for (int i = 0; i < 2; ++i) coff[h][i] = S.a_off(0, cur, HALF * h + Ra[i]) + Ca2[i];
    unsigned cB = (unsigned)cur.pn * tstep;
    PG8_STAGE_B(PG8_SB(0, 0), cB); PG8_STAGE_B(PG8_SB(0, 1), cB + hstep); PG8_STAGE_A(PG8_SA(0, 0), 0u, 0); PG8_STAGE_A(PG8_SA(0, 1), 0u, 1);
    if (wr == 1) PG8_BAR;
    PG8_WAIT_V(2); PG8_BAR;
    PG8_STAGE_B(PG8_SB(1, 0), cB + kstep); PG8_STAGE_A(PG8_SA(1, 0), kstep, 0); PG8_STAGE_B(PG8_SB(1, 1), cB + hstep + kstep);
    PG8_WAIT_V(6); PG8_BAR;
    for (;;) {
        const bool has_next = S.next(ui + 1, nxt);
        const unsigned nB = has_next ? (unsigned)nxt.pn * tstep : cB;
#pragma unroll 1
        for (int t = 0; t < nt; t += 2) {
            const bool last = (t == nt - 2);
            const unsigned k1 = (unsigned)(t + 1) * kstep;
            const unsigned k2 = last ? 0u : (unsigned)(t + 2) * kstep, k3 = k2 + kstep;
            const unsigned b2 = last ? nB : cB + (unsigned)(t + 2) * kstep, b3 = b2 + kstep;
            if (last) E.prefetch(cur, wr, wc, lane, epi);
            PG8_LDB(B0, 0, 0); PG8_LDB(B1, 0, 1); PG8_SCHED; PG8_LDA(At, 0, 0); PG8_STAGE_A(PG8_SA(1, 1), k1, 1);
            if (last && has_next) {
#pragma unroll
                for (int h = 0; h < 2; ++h)
#pragma unroll
                    for (int i = 0; i < 2; ++i) coff[h][i] = S.a_off(ui + 1, nxt, HALF * h + Ra[i]) + Ca2[i];
            }
            PG8_WAIT_V(8); PG8_WAIT_L(0); PG8_BAR; PG8_MMA(0, 0, At, B0); PG8_MMA(0, 1, At, B1); PG8_BAR; PG8_SCHED;
            PG8_LDA(At, 0, 1); PG8_STAGE_B(PG8_SB(0, 0), b2); PG8_STAGE_B(PG8_SB(0, 1), b2 + hstep); PG8_STAGE_A(PG8_SA(0, 0), k2, 0);
            PG8_WAIT_V(8); PG8_WAIT_L(0); PG8_BAR; PG8_MMA(1, 0, At, B0); PG8_MMA(1, 1, At, B1); PG8_BAR; PG8_SCHED;
            PG8_LDB(B0, 1, 0); PG8_LDB(B1, 1, 1); PG8_SCHED; PG8_LDA(At, 1, 0); PG8_STAGE_A(PG8_SA(0, 1), k2, 1);
            PG8_WAIT_V(8); PG8_WAIT_L(0); PG8_BAR; PG8_MMA(0, 0, At, B0); PG8_MMA(0, 1, At, B1); PG8_BAR; PG8_SCHED;
            PG8_LDA(At, 1, 1); PG8_STAGE_B(PG8_SB(1, 0), b3); PG8_STAGE_B(PG8_SB(1, 1), b3 + hstep); PG8_STAGE_A(PG8_SA(1, 0), k3, 0);
            PG8_WAIT_V(8); PG8_WAIT_L(0); PG8_BAR; PG8_MMA(1, 0, At, B0); PG8_MMA(1, 1, At, B1); PG8_BAR; PG8_SCHED;
        }
        if constexpr (ALIGN_EPI) { if (wr == 0) PG8_BAR; }
        E(acc, cur, wr, wc, fr, fq, (const LAS float*)epi);
        if (!has_next) break;
#pragma unroll
        for (int a = 0; a < 2; ++a)
#pragma unroll
            for (int b = 0; b < 2; ++b)
#pragma unroll
                for (int m = 0; m < 4; ++m)
#pragma unroll
                    for (int n = 0; n < 2; ++n) acc[a][b][m][n] = (f32x4){0.f, 0.f, 0.f, 0.f};
        cur = nxt; cB = nB; ++ui;
        if constexpr (ALIGN_EPI) { if (wr == 1) PG8_BAR; }
    }
    PG8_WAIT_V(0);
    if constexpr (!ALIGN_EPI) { if (wr == 0) PG8_BAR; }
    PG8_BAR;
#undef PG8_SA
#undef PG8_SB
#undef PG8_STAGE_A
#undef PG8_STAGE_B
#undef PG8_LD32
#undef PG8_LDA
#undef PG8_LDB
#undef PG8_MMA
#undef PG8_WAIT_V
#undef PG8_WAIT_L
#undef PG8_BAR
#undef PG8_SCHED
}

struct StaticOrder {
    int nM, nN, nwg, G, c, K;
    __device__ __forceinline__ void init(int M, int N, int K_, int G_, int c_) { nM = M / 256; nN = N / 256; nwg = nM * nN; G = G_; c = c_; K = K_; }
    __device__ __forceinline__ bool next(int i, Unit& u) const {
        const long L = (long)i * G + c; if (L >= nwg) return false;
        int wgid = (int)L; { const int q = nwg / 8, r = nwg % 8, xcd = wgid % 8, off = wgid / 8; wgid = (xcd < r ? xcd * (q + 1) : r * (q + 1) + (xcd - r) * q) + off; }
        const int nig = 8 * nN, gid = wgid / nig, fm = gid * 8, gsz = (nM - fm) < 8 ? (nM - fm) : 8;
        u.pm = fm + ((wgid % nig) % gsz); u.pn = (wgid % nig) / gsz; return true;
    }
    __device__ __forceinline__ unsigned a_off(int, const Unit& u, int r) const { return (unsigned)((u.pm * 256 + r) * K) * 2u; }
};
template <bool GATHER> struct MoeOrder {
    int NPN, start, end, per, slot, K  ; const LAS int* tile_e; const LAS unsigned short* tokl;
    __device__ __forceinline__ void init(int MT, int NPN_, int K_, int G, int c, const LAS int* tile_e_, const LAS unsigned short* tokl_) {
        NPN = NPN_; K = K_; tile_e = tile_e_; tokl = tokl_;
        const int U = MT * NPN, nx = (G % 8 == 0) ? 8 : 1; per = G / nx; const int x = c % nx; slot = c / nx;
        const int q = U / nx, r = U % nx; start = (x < r) ? x * (q + 1) : r * (q + 1) + (x - r) * q; end = start + ((x < r) ? q + 1 : q);
    }
    __device__ __forceinline__ bool next(int i, Unit& u) const { const int L = start + i * per + slot; if (L >= end) return false; const int mt = L / NPN, pn = L - mt * NPN; u.pm = mt; u.pn = tile_e[mt] * NPN + pn; return true; }
    __device__ __forceinline__ unsigned a_off(int ui, const Unit& u, int r) const { const unsigned row = GATHER ? (unsigned)tokl[ui * 256 + r] : (unsigned)(u.pm * 256 + r); return row * (unsigned)K; }
};

struct EpiInProj {
    bf16 *Q, *Kb, *V, *GB, *CU; const float* qw; const float* kw;
    __device__ __forceinline__ void prefetch(const Unit& u, int wr, int wc, int lane, LAS float* scr) const {
        __builtin_amdgcn_global_load_lds((const unsigned*)(((u.pn < 2) ? qw : kw) + lane), (LAS unsigned*)scr, 4, 0, 0); }
    __device__ __forceinline__ void operator()(const f32x4 (&acc)[2][2][4][2], const Unit& u, int wr, int wc, int fr, int fq, const LAS float* scr) const {
        const int row0 = u.pm * 256 + wr * 64 + fr, pn = u.pn;
        if (pn < 4) {
            const float sc = (pn < 2) ? C2 : 1.f; bf16* O = (pn < 2) ? Q : Kb;
            float w[2][2][4];
#pragma unroll
            for (int bj = 0; bj < 2; ++bj)
#pragma unroll
                for (int n = 0; n < 2; ++n) { const f32x4 t4 = *(const LAS f32x4*)(scr + 32 * bj + 8 * fq + 4 * n);
#pragma unroll
                    for (int i = 0; i < 4; ++i) w[bj][n][i] = t4[i] * sc; }
#pragma unroll
            for (int ai = 0; ai < 2; ++ai)
#pragma unroll
                for (int m = 0; m < 4; ++m) {
                    float ss = 0.f;
#pragma unroll
                    for (int bj = 0; bj < 2; ++bj)
#pragma unroll
                        for (int n = 0; n < 2; ++n) { const f32x4 v = acc[ai][bj][m][n]; ss += (v[0] * v[0] + v[1] * v[1]) + (v[2] * v[2] + v[3] * v[3]); }
                    ss += __shfl_xor(ss, 16); ss += __shfl_xor(ss, 32);
                    const float rstd = rsqrtf(ss * (1.f / 64.f) + EPS);
                    bf16* rowp = O + (size_t)(row0 + ai * 128 + m * 16) * DA + 256 * (pn & 1) + 64 * wc + 8 * fq;
#pragma unroll
                    for (int bj = 0; bj < 2; ++bj) { const f32x4 v0 = acc[ai][bj][m][0], v1 = acc[ai][bj][m][1]; u32x4 o;
                        o.x = cvtpk(v0[0] * rstd * w[bj][0][0], v0[1] * rstd * w[bj][0][1]); o.y = cvtpk(v0[2] * rstd * w[bj][0][2], v0[3] * rstd * w[bj][0][3]);
                        o.z = cvtpk(v1[0] * rstd * w[bj][1][0], v1[1] * rstd * w[bj][1][1]); o.w = cvtpk(v1[2] * rstd * w[bj][1][2], v1[3] * rstd * w[bj][1][3]);
                        *(u32x4*)(rowp + 32 * bj) = o; }
                }
        } else if (pn < 8) {
            bf16* O = (pn < 6) ? V : GB; const int ct = 256 * (pn & 1);
#pragma unroll
            for (int ai = 0; ai < 2; ++ai)
#pragma unroll
                for (int m = 0; m < 4; ++m) { bf16* rowp = O + (size_t)(row0 + ai * 128 + m * 16) * DA + ct + 32 * wc + 8 * fq;
#pragma unroll
                    for (int bj = 0; bj < 2; ++bj) { const f32x4 v0 = acc[ai][bj][m][0], v1 = acc[ai][bj][m][1]; u32x4 o;
                        o.x = cvtpk(v0[0], v0[1]); o.y = cvtpk(v0[2], v0[3]); o.z = cvtpk(v1[0], v1[1]); o.w = cvtpk(v1[2], v1[3]);
                        *(u32x4*)(rowp + 128 * bj) = o; } }
        } else {
            const int ct = 128 * (pn - 8);
#pragma unroll
            for (int ai = 0; ai < 2; ++ai)
#pragma unroll
                for (int m = 0; m < 4; ++m) { bf16* rowp = CU + (size_t)(row0 + ai * 128 + m * 16) * DC + ct + 32 * wc + 8 * fq;
                    const f32x4 v0 = acc[ai][0][m][0] * acc[ai][1][m][0], v1 = acc[ai][0][m][1] * acc[ai][1][m][1]; u32x4 o;
                    o.x = cvtpk(v0[0], v0[1]); o.y = cvtpk(v0[2], v0[3]); o.z = cvtpk(v1[0], v1[1]); o.w = cvtpk(v1[2], v1[3]);
                    *(u32x4*)rowp = o; }
        }
    }
};
struct EpiOutProj {
    bf16* D; const float* modf;
    __device__ __forceinline__ void prefetch(const Unit& u, int wr, int wc, int lane, LAS float* scr) const {
        const int b = (u.pm * 256) / SEQ, c0 = u.pn * 256 + 32 * wc;
        __builtin_amdgcn_global_load_lds((const unsigned*)(modf + (size_t)b * NMOD + 2 * DM + ((lane < 32) ? c0 + lane : c0 + 128 + lane - 32)), (LAS unsigned*)scr, 4, 0, 0); }
    __device__ __forceinline__ void operator()(const f32x4 (&acc)[2][2][4][2], const Unit& u, int wr, int wc, int fr, int fq, const LAS float* scr) const {
        const int row0 = u.pm * 256 + wr * 64 + fr, col0 = u.pn * 256 + 32 * wc + 8 * fq;
        f32x4 g[2][2];
#pragma unroll
        for (int bj = 0; bj < 2; ++bj)
#pragma unroll
            for (int n = 0; n < 2; ++n) g[bj][n] = *(const LAS f32x4*)(scr + 32 * bj + 8 * fq + 4 * n);
#pragma unroll
        for (int ai = 0; ai < 2; ++ai)
#pragma unroll
            for (int m = 0; m < 4; ++m) { bf16* rowp = D + (size_t)(row0 + ai * 128 + m * 16) * DM + col0;
#pragma unroll
                for (int bj = 0; bj < 2; ++bj) { const f32x4 v0 = g[bj][0] * acc[ai][bj][m][0], v1 = g[bj][1] * acc[ai][bj][m][1]; u32x4 o;
                    o.x = cvtpk(v0[0], v0[1]); o.y = cvtpk(v0[2], v0[3]); o.z = cvtpk(v1[0], v1[1]); o.w = cvtpk(v1[2], v1[3]);
                    store16_wt(rowp + 128 * bj, o); } }
    }
};
struct EpiGate {
    unsigned char* ACT; const float* bgu_all;
    __device__ __forceinline__ void prefetch(const Unit& u, int wr, int wc, int lane, LAS float* sc) const {
        const int e = u.pn >> 3, c0 = 128 * (u.pn & 7) + 32 * wc; const float* bgu = bgu_all + (size_t)e * 2 * DE;
        __builtin_amdgcn_global_load_lds((const unsigned*)(bgu + ((lane < 32) ? c0 + lane : DE + c0 + lane - 32)), (LAS unsigned*)sc, 4, 0, 0); }
    __device__ __forceinline__ void operator()(const f32x4 (&acc)[2][2][4][2], const Unit& u, int wr, int wc, int fr, int fq, const LAS float* sc) const {
        const int ch0 = 128 * (u.pn & 7) + 32 * wc + 8 * fq, slot0 = u.pm * 256;
        f32x4 bg[2], bu[2];
#pragma unroll
        for (int n = 0; n < 2; ++n) { bg[n] = *(const LAS f32x4*)(sc + 8 * fq + 4 * n); bu[n] = *(const LAS f32x4*)(sc + 32 + 8 * fq + 4 * n); }
#pragma unroll
        for (int ai = 0; ai < 2; ++ai)
#pragma unroll
            for (int m = 0; m < 4; ++m) { const int rl = ai * 128 + wr * 64 + m * 16 + fr; float a[8];
#pragma unroll
                for (int n = 0; n < 2; ++n)
#pragma unroll
                    for (int i = 0; i < 4; ++i) { float gt = acc[ai][0][m][n][i] * (1.f / WSCALE) + bg[n][i], up = acc[ai][1][m][n][i] * (1.f / WSCALE) + bu[n][i];
                        gt = fminf(gt, 7.f); up = fminf(fmaxf(up, -7.f), 7.f);
                        a[4 * n + i] = gt * __builtin_amdgcn_rcpf(1.f + __builtin_amdgcn_exp2f(-1.702f * LOG2E * gt)) * (up + 1.f); }
                u32x2 o; o.x = pack4_fp8(a[0], a[1], a[2], a[3]); o.y = pack4_fp8(a[4], a[5], a[6], a[7]);
                *(u32x2*)(ACT + (size_t)(slot0 + rl) * DE + ch0) = o; }
    }
};
struct EpiDown {
    unsigned char* Y; const float* bd_all; const float* roww_all; const LAS int* ecnt; const LAS int* etile0;
    __device__ __forceinline__ void prefetch(const Unit& u, int wr, int wc, int lane, LAS float* sc) const {
        const int e = u.pn >> 2, c0 = 256 * (u.pn & 3) + 32 * wc, lt = u.pm - etile0[e];
        const float* bd = bd_all + (size_t)e * DM; const float* roww = roww_all + (size_t)e * ECAP + lt * 256 + wr * 64 + lane;
        __builtin_amdgcn_global_load_lds((const unsigned*)(bd + ((lane < 32) ? c0 + lane : c0 + 128 + lane - 32)), (LAS unsigned*)sc, 4, 0, 0);
        __builtin_amdgcn_global_load_lds((const unsigned*)roww, (LAS unsigned*)(sc + 64), 4, 0, 0);
        __builtin_amdgcn_global_load_lds((const unsigned*)(roww + 128), (LAS unsigned*)(sc + 128), 4, 0, 0); }
    __device__ __forceinline__ void operator()(const f32x4 (&acc)[2][2][4][2], const Unit& u, int wr, int wc, int fr, int fq, const LAS float* sc) const {
        const int col0 = 256 * (u.pn & 3) + 32 * wc + 8 * fq, slot0 = u.pm * 256;
        f32x4 bv[2][2];
#pragma unroll
        for (int bj = 0; bj < 2; ++bj)
#pragma unroll
            for (int n = 0; n < 2; ++n) bv[bj][n] = *(const LAS f32x4*)(sc + 32 * bj + 8 * fq + 4 * n);
        const bool odd = (fq & 1) != 0; const int cb = col0 - 8 * (fq & 1);
#pragma unroll
        for (int ai = 0; ai < 2; ++ai)
#pragma unroll
            for (int mp = 0; mp < 2; ++mp) {
                u32x2 pk[2][2];
#pragma unroll
                for (int j = 0; j < 2; ++j) { const int m = 2 * mp + j; const float w = sc[64 + 64 * ai + 16 * m + fr] * YSCALE;
#pragma unroll
                    for (int bj = 0; bj < 2; ++bj) { const f32x4 v0 = (acc[ai][bj][m][0] * (1.f / WSCALE) + bv[bj][0]) * w, v1 = (acc[ai][bj][m][1] * (1.f / WSCALE) + bv[bj][1]) * w;
                        pk[j][bj].x = pack4_fp8(v0[0], v0[1], v0[2], v0[3]); pk[j][bj].y = pack4_fp8(v1[0], v1[1], v1[2], v1[3]); } }
                const int rl = ai * 128 + wr * 64 + (2 * mp + (odd ? 1 : 0)) * 16 + fr;
#pragma unroll
                for (int bj = 0; bj < 2; ++bj) { const u32x2 mine = odd ? pk[1][bj] : pk[0][bj], send = odd ? pk[0][bj] : pk[1][bj]; u32x2 got;
                    got.x = (unsigned)__shfl_xor((int)send.x, 16); got.y = (unsigned)__shfl_xor((int)send.y, 16);
                    u32x4 o; if (odd) { o.x = got.x; o.y = got.y; o.z = mine.x; o.w = mine.y; } else { o.x = mine.x; o.y = mine.y; o.z = got.x; o.w = got.y; }
                    *(u32x4*)(Y + (size_t)(slot0 + rl) * DM + cb + 128 * bj) = o; } }
    }
};


namespace attn_body {
using bf16x8=__attribute__((ext_vector_type(8)))short;
using s16x4=__attribute__((ext_vector_type(4)))short;
using f32x16=__attribute__((ext_vector_type(16)))float;
using u32x4=__attribute__((ext_vector_type(4)))unsigned;
typedef unsigned short bf16;
constexpr int BATCH=NB,NHEAD=NH,D=64,ADM=NHEAD*D;
constexpr int NW=8,QBLK=32,QB=QBLK*NW,KVBLK=64,NQB=SEQ/QB;
__device__ __forceinline__ int crow(int r,int hi){return (r&3)+8*(r>>2)+4*hi;}
#define SBAR() __builtin_amdgcn_sched_barrier(0)
__device__ __forceinline__ void cmask(f32x16&p0,f32x16&p1,int jb,int qrel,int hi){
  const float NEG=-INFINITY; int kb=64*jb+4*hi;
  #pragma unroll
  for(int r=0;r<16;++r){int kv=kb+(r&3)+8*(r>>2); if(kv>qrel)p0[r]=NEG; if(kv+32>qrel)p1[r]=NEG;}
}
constexpr int NSLOT=3, SLOTB=8192;
constexpr int LDS_K=0, LDS_V=NSLOT*SLOTB, LDS_WS=2*NSLOT*SLOTB, LDS_OST=LDS_WS+NW*64*4, LDS_FL=LDS_OST+NW*4096, LDS_BYTES_A=LDS_FL+SEQ*4;
__device__ __forceinline__ void glds16(const void*gsrc,unsigned lds_dst){unsigned keep;
  asm volatile("s_mov_b32 %0, m0\n\ts_mov_b32 m0, %2\n\ts_nop 0\n\tglobal_load_lds_dwordx4 %1, off\n\ts_mov_b32 m0, %0":"=&s"(keep):"v"(gsrc),"s"(lds_dst):"memory");}
__device__ __forceinline__ float max3f(float a,float b,float c){float r;asm("v_max3_f32 %0, %1, %2, %3":"=v"(r):"v"(a),"v"(b),"v"(c));return r;}
__device__ __forceinline__ float max2f(float a,float b){float r;asm("v_max_f32_e32 %0, %1, %2":"=v"(r):"v"(a),"v"(b));return r;}
__device__ __forceinline__ float fadd_s(float a,float b){float r;asm("v_add_f32_e32 %0, %1, %2":"=v"(r):"v"(a),"v"(b));return r;}
__device__ __forceinline__ float fsub_s(float a,float b){float r;asm("v_sub_f32_e32 %0, %1, %2":"=v"(r):"v"(a),"v"(b));return r;}
__device__ __forceinline__ unsigned cvtpk_s(float lo,float hi){f32x2 v={lo,hi};bf16x2_t b=__builtin_convertvector(v,bf16x2_t);return __builtin_bit_cast(unsigned,b);}
#define WAIT_BAR(N) asm volatile("s_waitcnt vmcnt(" #N ") lgkmcnt(0)\n\ts_barrier":::"memory")
typedef __attribute__((address_space(3))) const char* lds_cptr;
typedef short v4i16_t __attribute__((ext_vector_type(4)));
__device__ __forceinline__ void qkt(f32x16&p0,f32x16&p1,const char*Kslot,const bf16x8*qr,int r32,int hi){
  const char*kb=Kslot+hi*1024+r32*16;
  #pragma unroll
  for(int d0=0;d0<4;++d0){
    const bf16x8 b0=*reinterpret_cast<const bf16x8*>(kb+d0*2048);
    const bf16x8 b1=*reinterpret_cast<const bf16x8*>(kb+d0*2048+512);
    p0=__builtin_amdgcn_mfma_f32_32x32x16_bf16(b0,qr[d0],p0,0,0,0);p1=__builtin_amdgcn_mfma_f32_32x32x16_bf16(b1,qr[d0],p1,0,0,0);}
}
__device__ __forceinline__ void kload8(bf16x8*kf,lds_cptr kp){
  kf[0]=*(const __attribute__((address_space(3))) bf16x8*)(kp);      kf[1]=*(const __attribute__((address_space(3))) bf16x8*)(kp+512);
  kf[2]=*(const __attribute__((address_space(3))) bf16x8*)(kp+2048); kf[3]=*(const __attribute__((address_space(3))) bf16x8*)(kp+2560);
  kf[4]=*(const __attribute__((address_space(3))) bf16x8*)(kp+4096); kf[5]=*(const __attribute__((address_space(3))) bf16x8*)(kp+4608);
  kf[6]=*(const __attribute__((address_space(3))) bf16x8*)(kp+6144); kf[7]=*(const __attribute__((address_space(3))) bf16x8*)(kp+6656);
}
__device__ __forceinline__ void kload2(bf16x8*kf,lds_cptr kp,int j){ kf[2*j]=*(const __attribute__((address_space(3))) bf16x8*)(kp+j*2048); kf[2*j+1]=*(const __attribute__((address_space(3))) bf16x8*)(kp+j*2048+512); }
__device__ __forceinline__ s16x4 vtr(lds_cptr p){ return __builtin_bit_cast(s16x4,__builtin_amdgcn_ds_read_tr16_b64_v4i16((__attribute__((address_space(3))) v4i16_t*)p)); }
__device__ __forceinline__ float rowmax(const f32x16&p0,const f32x16&p1){
  float a=max3f(p0[0],p0[1],p1[0]),b=max3f(p0[2],p0[3],p1[1]);a=max3f(a,p1[2],p1[3]);
  #pragma unroll
  for(int r=4;r<16;r+=4){a=max3f(a,p0[r],p0[r+1]);b=max3f(b,p0[r+2],p0[r+3]);a=max3f(a,p1[r],p1[r+1]);b=max3f(b,p1[r+2],p1[r+3]);}
  const float m=max2f(a,b);
  auto rr=__builtin_amdgcn_permlane32_swap(__float_as_uint(m),__float_as_uint(m),false,false);
  return max2f(__uint_as_float(rr[0]),__uint_as_float(rr[1]));
}
__device__ __forceinline__ void pv(f32x16*o,int vb,bf16x8 pa0,bf16x8 pa1,bf16x8 pa2,bf16x8 pa3){
  #pragma unroll
  for(int d0=0;d0<2;++d0){s16x4 lo[4],hi[4];
    #pragma unroll
    for(int ks=0;ks<4;++ks){
      asm volatile("ds_read_b64_tr_b16 %0,%1 offset:%c2":"=&v"(lo[ks]):"v"(vb),"i"(d0*4096+ks*1024):"memory");
      asm volatile("ds_read_b64_tr_b16 %0,%1 offset:%c2":"=&v"(hi[ks]):"v"(vb),"i"(d0*4096+ks*1024+512):"memory");}
    asm volatile("s_waitcnt lgkmcnt(0)":::"memory");SBAR();
    #define PK(k) (bf16x8){lo[k][0],lo[k][1],lo[k][2],lo[k][3],hi[k][0],hi[k][1],hi[k][2],hi[k][3]}
    o[d0]=__builtin_amdgcn_mfma_f32_32x32x16_bf16(pa0,PK(0),o[d0],0,0,0);
    o[d0]=__builtin_amdgcn_mfma_f32_32x32x16_bf16(pa1,PK(1),o[d0],0,0,0);
    o[d0]=__builtin_amdgcn_mfma_f32_32x32x16_bf16(pa2,PK(2),o[d0],0,0,0);
    o[d0]=__builtin_amdgcn_mfma_f32_32x32x16_bf16(pa3,PK(3),o[d0],0,0,0);
    #undef PK
  }
}
typedef __attribute__((address_space(3))) const float* lds_fptr;
#define FLD(key0,g,half) (*(const __attribute__((address_space(3))) f32x4*)(flp+(key0)+32*(half)+8*(g)))
template<int THRL> __device__ __forceinline__ void attn_unit(int b,int h,int qb,const bf16*Q,const bf16*__restrict__ K,const bf16*__restrict__ V,bf16*O,char*shm){
  const int tid=opaque_tid(),lane=tid&63,r32=lane&31,hi=lane>>5; const int wid=__builtin_amdgcn_readfirstlane(tid>>6);
  const long rowbase=(long)b*SEQ; const int q0=qb*QB;
  const bf16*Qw=Q+(rowbase+q0+wid*QBLK)*ADM+h*D;
  const bf16*Kh=K+rowbase*ADM+h*D,*Vh=V+rowbase*ADM+h*D;
  const unsigned lds0=(unsigned)(uintptr_t)shm;
  float*wsf=(float*)(shm+LDS_WS)+wid*64;
  const bf16*ksrc=Kh+(long)lane*ADM+wid*8;
  const bf16*vsrc=Vh+(long)(16*(wid&3)+(lane>>2))*ADM+(wid>>2)*32+(lane&3)*8;
  const unsigned kdst=lds0+LDS_K+wid*1024, vdst=lds0+LDS_V+wid*1024;
  #define DMA_K(t,slot) glds16(ksrc+(long)(t)*KVBLK*ADM,(unsigned)__builtin_amdgcn_readfirstlane(kdst+(slot)))
  #define DMA_V(t,slot) glds16(vsrc+(long)(t)*KVBLK*ADM,(unsigned)__builtin_amdgcn_readfirstlane(vdst+(slot)))
  const int vb0=(int)(lds0+LDS_V)+((lane>>4)&1)*32+(lane&3)*8+(4*hi+((lane&15)>>2))*64;
  const char*Kbase=shm+LDS_K; bf16x8 kf[8];
  const lds_cptr shm3=(lds_cptr)shm; const lds_cptr kp0=shm3+LDS_K+hi*1024+r32*16; const lds_cptr vp0=shm3+LDS_V+((lane>>4)&1)*32+(lane&3)*8+(4*hi+((lane&15)>>2))*64;
  const lds_fptr flp=(lds_fptr)(shm3+LDS_FL)+4*hi;
  const int NT=(q0+QB)/KVBLK;
  DMA_K(0,0);DMA_V(0,0);DMA_K(1,SLOTB);
  bf16x8 qr[4];
  #pragma unroll
  for(int d0=0;d0<4;++d0)qr[d0]=*reinterpret_cast<const bf16x8*>(&Qw[(long)r32*ADM+d0*16+hi*8]);
  float mhat=0.f,l_reg=0.f;f32x16 o[2];o[0]=f32x16{};o[1]=f32x16{};
  const int qrel=wid*QBLK+r32;
  float nm=((lds_fptr)(shm3+LDS_FL))[q0+qrel];
  #define CMASK(P0,P1,t) do{int jb_=(t)-(NT-4); if(jb_>=0)cmask(P0,P1,jb_,qrel,hi);}while(0)
  bool resc=false;
  #define START(P0,P1) do{ const float rm=rowmax(P0,P1); resc=false; \
    { const float dl=rm; mhat=fadd_s(mhat,dl); nm=fsub_s(nm,dl); \
      _Pragma("unroll") for(int r=0;r<16;++r){P0[r]=fsub_s(P0[r],dl);P1[r]=fsub_s(P1[r],dl);} } \
    _Pragma("unroll") for(int r=0;r<16;++r)P0[r]=__builtin_amdgcn_exp2f(P0[r]); }while(0)
  #define RESC() do{ if(resc){ asm volatile("s_waitcnt lgkmcnt(0)":::"memory"); \
      _Pragma("unroll") for(int d_=0;d_<2;++d_) _Pragma("unroll") for(int r=0;r<16;++r)o[d_][r]*=wsf[crow(r,hi)]; } }while(0)
  f32x16 pA0,pA1,pB0,pB1;
  int sl_prev=0,sl_cur=0,sl_next=SLOTB;
  #define ROT() do{sl_prev=sl_cur;sl_cur=sl_next;sl_next=(sl_next==(NSLOT-1)*SLOTB)?0:sl_next+SLOTB;}while(0)
  DMA_K(2,2*SLOTB);
  #pragma unroll
  for(int g=0;g<4;++g){ const f32x4 f0=FLD(0,g,0), f1=FLD(0,g,1);
    #pragma unroll
    for(int j=0;j<4;++j){ pA0[4*g+j]=nm-f0[j]; pA1[4*g+j]=nm-f1[j]; } }
  WAIT_BAR(3);
  qkt(pA0,pA1,Kbase,qr,r32,hi);asm volatile("s_nop 15\n\ts_nop 7":"+v"(pA0),"+v"(pA1));CMASK(pA0,pA1,0);
  START(pA0,pA1);
  _Pragma("unroll") for(int r=0;r<16;++r)pA1[r]=__builtin_amdgcn_exp2f(pA1[r]);
  #pragma unroll
  for(int g=0;g<4;++g){ const f32x4 f0=FLD(64,g,0), f1=FLD(64,g,1);
    #pragma unroll
    for(int j=0;j<4;++j){ pB0[4*g+j]=nm-f0[j]; pB1[4*g+j]=nm-f1[j]; } }
  WAIT_BAR(0);
  DMA_K(3,0);DMA_V(1,SLOTB);
  ROT();
  kload8(kf,kp0+sl_cur);
  WAIT_BAR(2);
  s16x4 vlo[8],vhi[8]; u32x4 pw0,pw1,pw2,pw3;
  #define PKW(P,B) cvtpk_s(P[B],P[B+1])
  #define PAF(k) __builtin_bit_cast(bf16x8,pw##k)
  #define VFR(i) (bf16x8){vlo[i][0],vlo[i][1],vlo[i][2],vlo[i][3],vhi[i][0],vhi[i][1],vhi[i][2],vhi[i][3]}
  #define PIN(x) asm volatile("":"+v"(x))
  #define MX3(a,b,c) __builtin_fmaxf(__builtin_fmaxf((a),(b)),(c))
  #define GAPA(MF,A0,A1,A2,A3,W0,W1,PW) do{ MF; sacc+=A0; sacc+=A1; sacc+=A2; sacc+=A3; PIN(sacc); W0; W1; PIN(PW); SBAR(); }while(0)
  #define EX(v) __builtin_amdgcn_exp2f(v)
    \
  #define GAPB(MF,X,B,GF,NX,G,HALF,key0n) do{ MF; X[B]=EX(X[B]); X[B+1]=EX(X[B+1]); X[B+2]=EX(X[B+2]); X[B+3]=EX(X[B+3]); PIN(X); \
      if(GF){ const f32x4 f_=FLD(key0n,G,HALF); NX[4*(G)]=nm-f_[0]; NX[4*(G)+1]=nm-f_[1]; NX[4*(G)+2]=nm-f_[2]; NX[4*(G)+3]=nm-f_[3]; PIN(NX); } SBAR(); }while(0)
  #define VRD(i) do{ vlo[i]=vtr(vp_+(((i)>>2)*4096+((i)&3)*1024)); vhi[i]=vtr(vp_+(((i)>>2)*4096+((i)&3)*1024+512)); }while(0)
  #define KRD(G,j) do{ if(G){ kload2(kf,kp0+sl_next,j); SBAR(); } }while(0)
  #define STEP(C0,C1,P0,P1,t,GK,GV,GL) do{ SBAR(); \
    const lds_cptr vp_=vp0+sl_prev; const int kn_=64*((t)+1); \
    VRD(0); SBAR(); float sacc=(P0[0]+P0[1]); \
    GAPA(C0=__builtin_amdgcn_mfma_f32_32x32x16_bf16(kf[0],qr[0],C0,0,0,0), P0[2],P0[3],P0[4],P0[5],     pw0[0]=PKW(P0,0), pw0[1]=PKW(P0,2), pw0); \
    VRD(4); SBAR(); GAPA(C1=__builtin_amdgcn_mfma_f32_32x32x16_bf16(kf[1],qr[0],C1,0,0,0), P0[6],P0[7],P0[8],P0[9],     pw0[2]=PKW(P0,4), pw0[3]=PKW(P0,6), pw0); \
    VRD(1); SBAR(); GAPA(C0=__builtin_amdgcn_mfma_f32_32x32x16_bf16(kf[2],qr[1],C0,0,0,0),   P0[10],P0[11],P0[12],P0[13], pw1[0]=PKW(P0,8), pw1[1]=PKW(P0,10), pw1); \
    VRD(5); SBAR(); GAPA(C1=__builtin_amdgcn_mfma_f32_32x32x16_bf16(kf[3],qr[1],C1,0,0,0),   P0[14],P0[15],P1[0],P1[1],   pw1[2]=PKW(P0,12),pw1[3]=PKW(P0,14), pw1); \
    VRD(2); SBAR(); GAPA(C0=__builtin_amdgcn_mfma_f32_32x32x16_bf16(kf[4],qr[2],C0,0,0,0),   P1[2],P1[3],P1[4],P1[5],     pw2[0]=PKW(P1,0), pw2[1]=PKW(P1,2), pw2); \
    VRD(6); SBAR(); GAPA(C1=__builtin_amdgcn_mfma_f32_32x32x16_bf16(kf[5],qr[2],C1,0,0,0),   P1[6],P1[7],P1[8],P1[9],     pw2[2]=PKW(P1,4), pw2[3]=PKW(P1,6), pw2); \
    VRD(3); SBAR(); GAPA(C0=__builtin_amdgcn_mfma_f32_32x32x16_bf16(kf[6],qr[3],C0,0,0,0),   P1[10],P1[11],P1[12],P1[13], pw3[0]=PKW(P1,8), pw3[1]=PKW(P1,10), pw3); \
    VRD(7); SBAR(); GAPA(C1=__builtin_amdgcn_mfma_f32_32x32x16_bf16(kf[7],qr[3],C1,0,0,0),   P1[14],P1[15],0.f,0.f,       pw3[2]=PKW(P1,12),pw3[3]=PKW(P1,14), pw3); \
    l_reg+=sacc; \
    if(GK){DMA_K((t)+3,sl_cur);} if(GV){DMA_V((t)+1,sl_next);} \
    CMASK(C0,C1,t); \
    { float a=MX3(C0[0],C0[1],C1[0]),b=MX3(C0[2],C0[3],C1[1]); a=MX3(a,C1[2],C1[3]); \
      _Pragma("unroll") for(int r=4;r<16;r+=4){a=MX3(a,C0[r],C0[r+1]);b=MX3(b,C0[r+2],C0[r+3]);a=MX3(a,C1[r],C1[r+1]);b=MX3(b,C1[r+2],C1[r+3]);} \
      float rm=__builtin_fmaxf(a,b); { auto rr=__builtin_amdgcn_permlane32_swap(__float_as_uint(rm),__float_as_uint(rm),false,false); rm=__builtin_fmaxf(__uint_as_float(rr[0]),__uint_as_float(rr[1])); } \
      resc=false; \
      if(__builtin_expect(__any(rm>(float)THRL),0)){ const float dl=__builtin_fmaxf(rm,0.f); mhat+=dl; nm-=dl; \
        _Pragma("unroll") for(int r=0;r<16;++r){C0[r]-=dl;C1[r]-=dl;} \
        const float f=__builtin_amdgcn_exp2f(-dl); l_reg*=f; if(hi==0)wsf[r32]=f; resc=true; } } \
    SBAR(); \
    GAPB(o[0]=__builtin_amdgcn_mfma_f32_32x32x16_bf16(PAF(0),VFR(0),o[0],0,0,0), C0,0,  true,P0,0,0,kn_); \
    GAPB(o[1]=__builtin_amdgcn_mfma_f32_32x32x16_bf16(PAF(0),VFR(4),o[1],0,0,0), C0,4,  true,P0,1,0,kn_); \
    KRD(GL,0); GAPB(o[0]=__builtin_amdgcn_mfma_f32_32x32x16_bf16(PAF(1),VFR(1),o[0],0,0,0), C0,8,  true,P0,2,0,kn_); \
    KRD(GL,1); GAPB(o[1]=__builtin_amdgcn_mfma_f32_32x32x16_bf16(PAF(1),VFR(5),o[1],0,0,0), C0,12, true,P0,3,0,kn_); \
    KRD(GL,2); GAPB(o[0]=__builtin_amdgcn_mfma_f32_32x32x16_bf16(PAF(2),VFR(2),o[0],0,0,0), C1,0,  true,P1,0,1,kn_); \
    KRD(GL,3); GAPB(o[1]=__builtin_amdgcn_mfma_f32_32x32x16_bf16(PAF(2),VFR(6),o[1],0,0,0), C1,4,  true,P1,1,1,kn_); \
    GAPB(o[0]=__builtin_amdgcn_mfma_f32_32x32x16_bf16(PAF(3),VFR(3),o[0],0,0,0), C1,8,  true,P1,2,1,kn_); \
    GAPB(o[1]=__builtin_amdgcn_mfma_f32_32x32x16_bf16(PAF(3),VFR(7),o[1],0,0,0), C1,12, true,P1,3,1,kn_); \
    }while(0)
  int t=1;
  #undef CMASK
  #define CMASK(P0,P1,t) do{}while(0)
  for(;t+5<NT;t+=2){
    STEP(pB0,pB1,pA0,pA1,t,true,true,true);     WAIT_BAR(2); RESC(); ROT();
    STEP(pA0,pA1,pB0,pB1,t+1,true,true,true);   WAIT_BAR(2); RESC(); ROT();
  }
  #undef CMASK
  #define CMASK(P0,P1,t) do{int jb_=(t)-(NT-4); if(jb_>=0)cmask(P0,P1,jb_,qrel,hi);}while(0)
  #define ENDW(tt) do{ if((tt)+3<NT){WAIT_BAR(2);} else if((tt)+2<NT){WAIT_BAR(1);} else {WAIT_BAR(0);} }while(0)
  for(;t+1<NT;t+=2){
    STEP(pB0,pB1,pA0,pA1,t,(t+3<NT),(t+1<NT),(t+1<NT));       ENDW(t);   RESC(); ROT();
    STEP(pA0,pA1,pB0,pB1,t+1,(t+4<NT),(t+2<NT),(t+2<NT));     ENDW(t+1); RESC(); ROT();
  }
  STEP(pB0,pB1,pA0,pA1,NT-1,false,false,false); RESC();
  { float sacc=pB0[0]+pB0[1]; _Pragma("unroll") for(int r=2;r<16;++r)sacc+=pB0[r]; _Pragma("unroll") for(int r=0;r<16;++r)sacc+=pB1[r]; l_reg+=sacc;
    pw0=(u32x4){PKW(pB0,0),PKW(pB0,2),PKW(pB0,4),PKW(pB0,6)};pw1=(u32x4){PKW(pB0,8),PKW(pB0,10),PKW(pB0,12),PKW(pB0,14)};pw2=(u32x4){PKW(pB1,0),PKW(pB1,2),PKW(pB1,4),PKW(pB1,6)};pw3=(u32x4){PKW(pB1,8),PKW(pB1,10),PKW(pB1,12),PKW(pB1,14)};
    SBAR(); pv(o,vb0+sl_cur,PAF(0),PAF(1),PAF(2),PAF(3)); }
  #undef PKW
  #undef PAF
  #undef VFR
  #undef PIN
  #undef MX3
  #undef GAPA
  #undef GAPB
  #undef EX
  #undef VRD
  #undef KRD
  #undef STEP
  #undef ENDW
  {auto rr=__builtin_amdgcn_permlane32_swap(__float_as_uint(l_reg),__float_as_uint(l_reg),false,false);l_reg=__uint_as_float(rr[0])+__uint_as_float(rr[1]);}
  if(hi==0)wsf[32+r32]=l_reg;asm volatile("s_waitcnt lgkmcnt(0)":::"memory");
  float rli[16];
  #pragma unroll
  for(int r=0;r<16;++r)rli[r]=__builtin_amdgcn_rcpf(wsf[32+crow(r,hi)]);
  bf16*Ow=O+(rowbase+q0+wid*QBLK)*ADM+h*D;
  { bf16*stg=(bf16*)(shm+LDS_OST)+wid*2048;
    #pragma unroll
    for(int r=0;r<16;++r){const int orow=crow(r,hi);
      #pragma unroll
      for(int d0=0;d0<2;++d0){ const unsigned w=cvtpk_s(o[d0][r]*rli[r],0.f); stg[orow*64+d0*32+r32]=(bf16)(w&0xffffu); } }
    asm volatile("s_waitcnt lgkmcnt(0)":::"memory");
    #pragma unroll
    for(int i=0;i<4;++i){const int row=i*8+(lane>>3),ch=lane&7; const u32x4 v=*(const u32x4*)(stg+row*64+ch*8); *(u32x4*)(Ow+(long)row*ADM+ch*8)=v;} }
  asm volatile("s_waitcnt lgkmcnt(0)\n\ts_barrier":::"memory");
  #undef DMA_K
  #undef DMA_V
  #undef CMASK
  #undef START
  #undef RESC
  #undef ROT
}
#undef FLD
#undef SBAR
#undef WAIT_BAR
}

template <int N> __device__ __forceinline__ int dpp_ror_i(int x) { return __builtin_amdgcn_update_dpp(0, x, 0x120 + N, 0xf, 0xf, false); }
template <int N> __device__ __forceinline__ float dpp_ror_f(float x) { return __builtin_bit_cast(float, __builtin_amdgcn_update_dpp(0, __builtin_bit_cast(int, x), 0x120 + N, 0xf, 0xf, false)); }
template <int N> struct RankStep {
    static __device__ __forceinline__ void run(float v0, float v1, int fr, int& rank0, int& rank1) {
        const float ov0 = dpp_ror_f<N>(v0), ov1 = dpp_ror_f<N>(v1); const bool lower = dpp_ror_i<N>(fr) < fr;
        rank0 += ((ov0 > v0 || (ov0 == v0 && lower)) ? 1 : 0) + ((ov1 > v0) ? 1 : 0);
        rank1 += ((ov0 >= v1) ? 1 : 0) + ((ov1 > v1 || (ov1 == v1 && lower)) ? 1 : 0);
        RankStep<N + 1>::run(v0, v1, fr, rank0, rank1); } };
template <> struct RankStep<16> { static __device__ __forceinline__ void run(float, float, int, int&, int&) {} };
__global__ void __launch_bounds__(NTHR, 2) fwd_kernel(Args A) {
    extern __shared__ __attribute__((aligned(16))) unsigned char lds_raw[];
    LAS unsigned char* lds = (LAS unsigned char*)lds_raw;
    volatile LAS unsigned* MISC = (volatile LAS unsigned*)(lds + MISC_OFF);
    const int tid = threadIdx.x, lane = tid & 63, wave = __builtin_amdgcn_readfirstlane(tid >> 6);
    const int G = gridDim.x, bid = blockIdx.x;
    const int gw = bid * NWAVES + wave, NGW = G * NWAVES;
    unsigned char* ws = A.ws;
    unsigned* ctl = (unsigned*)(ws + WS_CTL);
    float* modp = (float*)(ws + WS_MODP); float* modf = (float*)(ws + WS_MODF); float* Wfc = (float*)(ws + WS_WFC); unsigned char* WRAg = ws + WS_WRA; float* cstp = (float*)(ws + WS_CSTP);
    float* lcb = (float*)(ws + WS_LC); float* totb = (float*)(ws + WS_TOT);
    bf16* Win_t = (bf16*)(ws + WS_WIN); bf16* Wout_t = (bf16*)(ws + WS_WOUT); unsigned char* Wgu8 = ws + WS_WGU; unsigned char* Wd8 = ws + WS_WD;
    bf16* Hb = (bf16*)(ws + WS_H); bf16* Qb = (bf16*)(ws + WS_Q); bf16* Kb = (bf16*)(ws + WS_K); bf16* Vb = (bf16*)(ws + WS_V); bf16* Ob = (bf16*)(ws + WS_O);
    bf16* GBb = (bf16*)(ws + WS_GB); bf16* CUb = (bf16*)(ws + WS_CU); bf16* MIXb = (bf16*)(ws + WS_MIX); bf16* DELTAb = (bf16*)(ws + WS_GB);
    int* tokslot = (int*)(ws + WS_TOKSLOT); int* rowtok = (int*)(ws + WS_ROWTOK); float* roww = (float*)(ws + WS_ROWW);
    unsigned char* ACT8 = ws + WS_ACT; unsigned char* Y8 = ws + WS_Y; unsigned char* H8 = ws + WS_H;
    unsigned* gcnt = ctl + CW_CNT;

    for (int u = tid; u < 128; u += NTHR) MISC[u] = 0u;
    __syncthreads();
    XcdBarrier bar = xcd_barrier_post(ctl + CW_BAR, MISC + 8);

    {
        const int tid = opaque_tid(), lane = tid & 63, wave = __builtin_amdgcn_readfirstlane(tid >> 6), gw = bid * NWAVES + wave; (void)lane; (void)gw;
        LAS float* silu_tab = (LAS float*)lds;
        for (int i = tid; i < NB * DM; i += NTHR) { const int b = i / DM, k = i % DM; silu_tab[k * 8 + b] = siluf(A.c[i]); }
        __syncthreads();
        if (bid == G - 1) { for (int i = wave * 1024 + lane; i < wave * 1024 + 1024; i += 64) Wfc[i] = A.w_in[(size_t)(i >> 3) * NIN + COL_F + (i & 7)]; }
        if (gw % 5 == 0 && gw / 5 < 384) {
            const int it = gw / 5, cg = it >> 2, ks = it & 3, col = 64 * cg + lane;
            float acc[8] = {0.f, 0.f, 0.f, 0.f, 0.f, 0.f, 0.f, 0.f};
            const float* wp = A.w_ada + (size_t)(256 * ks) * NMOD + col;
#pragma unroll 1
            for (int k0 = 0; k0 < 256; k0 += 16) { float w[16];
#pragma unroll
                for (int k = 0; k < 16; ++k) w[k] = __builtin_nontemporal_load(wp + (size_t)(k0 + k) * NMOD);
#pragma unroll
                for (int k = 0; k < 16; ++k) { const f32x4 s0 = *(const LAS f32x4*)(silu_tab + (256 * ks + k0 + k) * 8), s1 = *(const LAS f32x4*)(silu_tab + (256 * ks + k0 + k) * 8 + 4);
                    acc[0] += s0[0] * w[k]; acc[1] += s0[1] * w[k]; acc[2] += s0[2] * w[k]; acc[3] += s0[3] * w[k]; acc[4] += s1[0] * w[k]; acc[5] += s1[1] * w[k]; acc[6] += s1[2] * w[k]; acc[7] += s1[3] * w[k]; } }
#pragma unroll
            for (int b = 0; b < 8; ++b) modp[(size_t)(ks * 8 + b) * NMOD + col] = acc[b];
        }
        { const int tid = opaque_tid(), lane = tid & 63; (void)tid;
        LAS unsigned* scr = (LAS unsigned*)(lds + 32768 + wave * 4352);
        constexpr int I_IN = 96 * 16, I_OUT = 32 * 16, NITEMS = I_IN + I_OUT;
        constexpr int I_GU = NE * 64 * 8, I_D = NE * 32 * 8, NITEMS8 = I_GU + I_D;
        for (int it = gw; it < NITEMS; it += NGW) {
            TItem ti; int r = it;
            if (r < I_IN) { const int g = r >> 4, kb = r & 15; ti = TItem{A.w_in + (size_t)(64 * kb) * NIN + win_src_col(g), Win_t + (size_t)(32 * g) * DM + 64 * kb, NIN, DM}; }
            else { r -= I_IN; const int g = r >> 4, kb = r & 15; ti = TItem{A.w_out + (size_t)(64 * kb) * DM + 32 * g, Wout_t + (size_t)(32 * g) * DM + 64 * kb, DM, DM}; }
            f32x4 va[8]; titem_load(ti, lane, va); titem_store(ti, lane, va, scr);
        }
        auto decode8 = [&](int it) -> TItem8 {
            int r = it;
            if (r < I_GU) { const int e = r >> 9, g = (r >> 3) & 63, kb = r & 7; const int pn = g >> 3, p0 = (g & 7) * 32, bj = p0 >> 7, wc = (p0 >> 5) & 3;
                return TItem8{A.w_gate_up + (size_t)e * DM * 2 * DE + (size_t)(128 * kb) * 2 * DE + (bj ? DE : 0) + 128 * pn + 32 * wc, Wgu8 + ((size_t)e * 2 * DE + 32 * g) * DM + 128 * kb, 2 * DE, DM}; }
            r -= I_GU;
            { const int e = r >> 8, g = (r >> 3) & 31, kb = r & 7;
                return TItem8{A.w_down + (size_t)e * DE * DM + (size_t)(128 * kb) * DM + 32 * g, Wd8 + ((size_t)e * DM + 32 * g) * DE + 128 * kb, DM, DE}; }
        };
        if (gw < NITEMS8) {
            f32x4 va[16], vb[16]; TItem8 ta = decode8(gw), tb = ta;
            titem8_load(ta, lane, va);
            for (int it = gw; it < NITEMS8; it += 2 * NGW) {
                if (it + NGW < NITEMS8) { tb = decode8(it + NGW); titem8_load(tb, lane, vb); }
                titem8_store(ta, lane, va, scr);
                if (it + NGW < NITEMS8) {
                    if (it + 2 * NGW < NITEMS8) { ta = decode8(it + 2 * NGW); titem8_load(ta, lane, va); }
                    titem8_store(tb, lane, vb, scr);
                }
            }
        }
        }
    }
    xcd_barrier(bar);

    {
        const int tid = opaque_tid(), lane = tid & 63, wave = __builtin_amdgcn_readfirstlane(tid >> 6), gw = bid * NWAVES + wave; (void)lane; (void)gw;
        LAS float* tabA = (LAS float*)lds; LAS float* tabB = tabA + DM; LAS f32x4* Wf4 = (LAS f32x4*)(tabB + DM)  ; LAS float* lfs = (LAS float*)(Wf4 + 2 * DM)  ;
        for (int rb = bid; rb < T / 64; rb += G) {
            const int b = rb / (SEQ / 64);
            f32x4 v[8][4];
#pragma unroll
            for (int i = 0; i < 8; ++i) { const f32x4* xr = (const f32x4*)(A.x + (size_t)(rb * 64 + wave * 8 + i) * DM) + lane;
#pragma unroll
                for (int j = 0; j < 4; ++j) v[i][j] = __builtin_nontemporal_load(xr + 64 * j); }
            if (tid < DM / 4) {
                const int k = 4 * tid; f32x4 sh = *(const f32x4*)(A.b_ada + k), sc = *(const f32x4*)(A.b_ada + DM + k);
#pragma unroll
                for (int p = 0; p < 4; ++p) { sh += *(const f32x4*)(modp + (size_t)(p * 8 + b) * NMOD + k); sc += *(const f32x4*)(modp + (size_t)(p * 8 + b) * NMOD + DM + k); }
                const f32x4 nw = *(const f32x4*)(A.norm1_w + k);
                *(LAS f32x4*)(tabA + k) = nw * (1.f + sc); *(LAS f32x4*)(tabB + k) = sh; }
            else { const int k = tid - DM / 4;
#pragma unroll
                for (int q = 0; q < 4; ++q) { const int kk = k + 256 * q; const int prow = (kk & ~63) | ((kk & 3) << 4) | ((kk >> 2) & 15);
                    Wf4[prow] = *(const f32x4*)(Wfc + kk * 8); Wf4[DM + prow] = *(const f32x4*)(Wfc + kk * 8 + 4); } }
            for (int i = bid * NTHR + tid; i < NB * NMOD / 4; i += G * NTHR) { const int bb = (4 * i) / NMOD, j = (4 * i) % NMOD; f32x4 s = *(const f32x4*)(A.b_ada + j);
#pragma unroll
                for (int p = 0; p < 4; ++p) s += *(const f32x4*)(modp + (size_t)(p * 8 + bb) * NMOD + j);
                *(f32x4*)(modf + 4 * (size_t)i) = s; }
            __syncthreads();
            const float bfg = A.b_forget[(lane >> 3) & 7];
#pragma unroll
            for (int i = 0; i < 8; ++i) {
                const int rl = wave * 8 + i, row = rb * 64 + rl;
                float ss = 0.f;
#pragma unroll
                for (int j = 0; j < 4; ++j) ss += (v[i][j][0] * v[i][j][0] + v[i][j][1] * v[i][j][1]) + (v[i][j][2] * v[i][j][2] + v[i][j][3] * v[i][j][3]);
                const float rstd = rsqrtf(wave_sum(ss) * (1.f / DM) + EPS);
                float fa[8] = {0.f, 0.f, 0.f, 0.f, 0.f, 0.f, 0.f, 0.f};
                u32x2* o8 = (u32x2*)(Hb + (size_t)row * DM) + lane;
#pragma unroll
                for (int j = 0; j < 4; ++j) { const int k4 = lane + 64 * j; const f32x4 a = *(const LAS f32x4*)(tabA + 4 * k4), bb = *(const LAS f32x4*)(tabB + 4 * k4);
                    const f32x4 h = v[i][j] * rstd * a + bb;
                    u32x2 o; o.x = cvtpk(h[0], h[1]); o.y = cvtpk(h[2], h[3]); o8[64 * j] = o;
#pragma unroll
                    for (int c = 0; c < 4; ++c) { const int prow = 256 * j + 64 * (lane >> 4) + 16 * c + (lane & 15); const f32x4 w0 = Wf4[prow], w1 = Wf4[DM + prow];
                        fa[0] += h[c] * w0[0]; fa[1] += h[c] * w0[1]; fa[2] += h[c] * w0[2]; fa[3] += h[c] * w0[3]; fa[4] += h[c] * w1[0]; fa[5] += h[c] * w1[1]; fa[6] += h[c] * w1[2]; fa[7] += h[c] * w1[3]; } }
                { const bool u5 = (lane & 32) != 0, u4 = (lane & 16) != 0, u3 = (lane & 8) != 0;
#pragma unroll
                  for (int q = 0; q < 4; ++q) { const float lo = fa[q], hi = fa[q + 4]; fa[q] = (u5 ? hi : lo) + __shfl_xor(u5 ? lo : hi, 32); }
#pragma unroll
                  for (int q = 0; q < 2; ++q) { const float lo = fa[q], hi = fa[q + 2]; fa[q] = (u4 ? hi : lo) + __shfl_xor(u4 ? lo : hi, 16); }
                  { const float lo = fa[0], hi = fa[1]; fa[0] = (u3 ? hi : lo) + __shfl_xor(u3 ? lo : hi, 8); }
                  fa[0] += __shfl_xor(fa[0], 4); fa[0] += __shfl_xor(fa[0], 2); fa[0] += __shfl_xor(fa[0], 1); }
                if ((lane & 7) == 0) { const float z = fa[0] + bfg; const float ls = (z < 0.f) ? (z - log1pf(__expf(z))) : (-log1pf(__expf(-z))); lfs[rl * 8 + ((lane >> 3) & 7)] = ls * LOG2E; }
            }
            __syncthreads();
            if (wave == 0) {
                const int sb = rb % (SEQ / 64);
#pragma unroll
                for (int j = 0; j < 8; ++j) { float s = lfs[lane * 8 + j];
#pragma unroll
                    for (int o = 1; o < 64; o <<= 1) { const float t = __shfl_up(s, o); if (lane >= o) s += t; }
                    lcb[(size_t)(b * NH + j) * SEQ + sb * 64 + lane] = s; if (lane == 63) totb[(b * NH + j) * 32 + sb] = s; }
            }
            { const int bq = rb >> 5, ks = rb & 31; LAS float* red = lfs + 512;
              if (tid < 256) { const int k = 32 * ks + (tid >> 3), c4 = tid & 7; const int i4 = 4 * DM + k, i3 = 3 * DM + k;
                  float sc = A.b_ada[i4], sh = A.b_ada[i3];
#pragma unroll
                  for (int p = 0; p < 4; ++p) { sc += modp[(size_t)(p * 8 + bq) * NMOD + i4]; sh += modp[(size_t)(p * 8 + bq) * NMOD + i3]; }
                  const float a = A.norm2_w[k] * (1.f + sc); const f32x4 w = *(const f32x4*)(A.w_router + (size_t)k * NE + 4 * c4);
                  unsigned char* wp = WRAg + (size_t)bq * 65536 + ((c4 >> 2) * 32 + ks) * 1024 + ((((k >> 3) & 3) * 16 + 4 * (c4 & 3))) * 16 + (k & 7) * 2;
#pragma unroll
                  for (int q = 0; q < 4; ++q) *(unsigned short*)(wp + 16 * q) = (unsigned short)(cvtpk(w[q] * a, 0.f) & 0xffffu);
                  *(LAS f32x4*)(red + 4 * tid) = w * sh; }
              __syncthreads();
              if (tid < 32) { const int c4 = tid >> 2, q = tid & 3; float s = 0.f; for (int t2 = 0; t2 < 32; ++t2) s += red[4 * (8 * t2 + c4) + q]; cstp[((size_t)bq * 32 + ks) * 32 + tid] = s; } }
            __syncthreads();
        }
    }
    xcd_barrier(bar);

    {
        const int tid = opaque_tid(), lane = tid & 63, wave = __builtin_amdgcn_readfirstlane(tid >> 6), gw = bid * NWAVES + wave; (void)lane; (void)gw;
        EpiInProj E{Qb, Kb, Vb, GBb, CUb, A.q_norm_w, A.k_norm_w};
        StaticOrder S; S.init(T, 3072, DM, G, bid);
        gemm_phase<EpiInProj, StaticOrder, true>(lds, Hb, Win_t, DM, S, E);
    }
    xcd_barrier(bar);

    {
        const int tid = opaque_tid(), lane = tid & 63, wave = __builtin_amdgcn_readfirstlane(tid >> 6), gw = bid * NWAVES + wave; (void)lane; (void)gw;
        char* shm = (char*)lds_raw;
        LAS float* FL = (LAS float*)(lds + attn_body::LDS_FL);
        const int vcu = (G % 8 == 0) ? (bid % 8) * (G / 8) + bid / 8 : bid;
        for (int v = vcu; v < 256; v += G) {
            const int bh = v >> 2, s = v & 3, b = bh >> 3, h = bh & 7;
            { float pre = 0.f; const float tv = (lane < 32) ? totb[bh * 32 + lane] : 0.f; float sc = tv;
#pragma unroll
              for (int o = 1; o < 32; o <<= 1) { const float t2 = __shfl_up(sc, o); if (lane >= o) sc += t2; }
              sc -= tv;
              for (int i = 0; i < 4; ++i) { const int t = tid + NTHR * i; pre = __shfl(sc, t >> 6); FL[t] = pre + lcb[(size_t)bh * SEQ + t]; } }
            VM_WAIT(); __syncthreads();
            attn_body::attn_unit<8>(b, h, s, Qb, Kb, Vb, Ob, shm);
            attn_body::attn_unit<8>(b, h, 7 - s, Qb, Kb, Vb, Ob, shm);
            __syncthreads();
        }
    }
    xcd_barrier(bar);

    {
        const int tid = opaque_tid(), lane = tid & 63, wave = __builtin_amdgcn_readfirstlane(tid >> 6), gw = bid * NWAVES + wave; (void)lane; (void)gw;
        float cw[3][8], wa[8], wcn[8];
#pragma unroll
        for (int i = 0; i < 8; ++i) { cw[0][i] = A.conv_w[0 * DC + 8 * lane + i]; cw[1][i] = A.conv_w[1 * DC + 8 * lane + i]; cw[2][i] = A.conv_w[2 * DC + 8 * lane + i];
            wa[i] = A.attn_out_norm_w[8 * lane + i]; wcn[i] = A.conv_out_norm_w[8 * lane + i]; }
        for (int rg = gw; rg < T / 8; rg += NGW) {
            const int r0 = rg * 8; const bool head = (r0 % SEQ) == 0;
            u32x4 ow[8], gbw[8], cu[10];
            const u32x4 zero = {0u, 0u, 0u, 0u};
#pragma unroll
            for (int i = 0; i < 8; ++i) { ow[i] = __builtin_nontemporal_load((const u32x4*)(Ob + (size_t)(r0 + i) * DA + 8 * lane)); gbw[i] = __builtin_nontemporal_load((const u32x4*)(GBb + (size_t)(r0 + i) * DC + 8 * lane)); cu[i + 2] = *(const u32x4*)(CUb + (size_t)(r0 + i) * DC + 8 * lane); }
            cu[0] = head ? zero : *(const u32x4*)(CUb + (size_t)(r0 - 2) * DC + 8 * lane); cu[1] = head ? zero : *(const u32x4*)(CUb + (size_t)(r0 - 1) * DC + 8 * lane);
#pragma unroll
            for (int r = 0; r < 8; ++r) {
                float a[8], y[8]; float ssa = 0.f, ssc = 0.f;
#pragma unroll
                for (int i = 0; i < 4; ++i) { const unsigned w_o = ow[r][i], w_g = gbw[r][i], w0 = cu[r + 2][i], w1 = cu[r + 1][i], w2 = cu[r][i];
                    a[2 * i] = bf_lo(w_o); a[2 * i + 1] = bf_hi(w_o);
                    y[2 * i] = bf_lo(w_g) * (cw[0][2 * i] * bf_lo(w2) + cw[1][2 * i] * bf_lo(w1) + cw[2][2 * i] * bf_lo(w0));
                    y[2 * i + 1] = bf_hi(w_g) * (cw[0][2 * i + 1] * bf_hi(w2) + cw[1][2 * i + 1] * bf_hi(w1) + cw[2][2 * i + 1] * bf_hi(w0)); }
#pragma unroll
                for (int i = 0; i < 8; ++i) { ssa += a[i] * a[i]; ssc += y[i] * y[i]; }
                const float ra = rsqrtf(wave_sum(ssa) * (1.f / DA) + EPS), rc = rsqrtf(wave_sum(ssc) * (1.f / DC) + EPS);
                u32x4 oa, oc;
                oa.x = cvtpk(a[0] * ra * wa[0], a[1] * ra * wa[1]); oa.y = cvtpk(a[2] * ra * wa[2], a[3] * ra * wa[3]); oa.z = cvtpk(a[4] * ra * wa[4], a[5] * ra * wa[5]); oa.w = cvtpk(a[6] * ra * wa[6], a[7] * ra * wa[7]);
                oc.x = cvtpk(y[0] * rc * wcn[0], y[1] * rc * wcn[1]); oc.y = cvtpk(y[2] * rc * wcn[2], y[3] * rc * wcn[3]); oc.z = cvtpk(y[4] * rc * wcn[4], y[5] * rc * wcn[5]); oc.w = cvtpk(y[6] * rc * wcn[6], y[7] * rc * wcn[7]);
                store16_wt(MIXb + (size_t)(r0 + r) * DM + 8 * lane, oa); store16_wt(MIXb + (size_t)(r0 + r) * DM + DA + 8 * lane, oc);
            }
        }
    }
    xcd_barrier(bar);

    {
        const int tid = opaque_tid(), lane = tid & 63, wave = __builtin_amdgcn_readfirstlane(tid >> 6), gw = bid * NWAVES + wave; (void)lane; (void)gw;
        EpiOutProj E{DELTAb, modf};
        StaticOrder S; S.init(T, DM, DM, G, bid);
        gemm_phase<EpiOutProj, StaticOrder, false>(lds, MIXb, Wout_t, DM, S, E);
    }
    xcd_barrier(bar);

    {
        const int tid = opaque_tid(), lane = tid & 63, wave = __builtin_amdgcn_readfirstlane(tid >> 6), gw = bid * NWAVES + wave; (void)lane; (void)gw;
        LAS unsigned char* WRA = lds; LAS unsigned char* XT = lds + 65536;
        LAS float* tabA = (LAS float*)(lds + 131072); LAS float* tabB = tabA + DM;
        LAS float* cst = tabB + DM  ; LAS float* rstdv = cst + 32  ;
        LAS int* lcnt = (LAS int*)(rstdv + 64); LAS int* lbase = lcnt + 32; LAS int* asg_e = lbase + 32; LAS int* asg_r = asg_e + 256; LAS float* asg_w = (LAS float*)(asg_r + 256);
        for (int rb = bid; rb < T / 64; rb += G) {
            const int tid = opaque_tid(), lane = tid & 63;
            const int b = rb / (SEQ / 64);
            f32x4 v[8][4];
#pragma unroll
            for (int r = 0; r < 8; ++r) { const size_t ro = (size_t)(rb * 64 + wave * 8 + r) * DM; const f32x4* xr = (const f32x4*)(A.x + ro) + lane; const u32x2* dr = (const u32x2*)(DELTAb + ro) + lane;
#pragma unroll
                for (int j = 0; j < 4; ++j) { const f32x4 xv = __builtin_nontemporal_load(xr + 64 * j); const u32x2 dv = dr[64 * j];
                    v[r][j] = xv + (f32x4){bf_lo(dv.x), bf_hi(dv.x), bf_lo(dv.y), bf_hi(dv.y)}; } }
            if (tid < DM / 4) { const int k = 4 * tid; *(LAS f32x4*)(tabA + k) = *(const f32x4*)(A.norm2_w + k) * (1.f + *(const f32x4*)(modf + (size_t)b * NMOD + 4 * DM + k)); *(LAS f32x4*)(tabB + k) = *(const f32x4*)(modf + (size_t)b * NMOD + 3 * DM + k); }
            if (tid < 32) lcnt[tid] = 0;
            __syncthreads();
#pragma unroll
            for (int p = 0; p < 8; ++p) __builtin_amdgcn_global_load_lds((const unsigned*)(WRAg + (size_t)b * 65536 + (wave * 8 + p) * 1024 + lane * 16), (LAS unsigned*)(WRA + (wave * 8 + p) * 1024), 16, 0, 0);
            if (tid < 32) { float s = A.b_router[tid]; for (int t2 = 0; t2 < 32; ++t2) s += cstp[((size_t)b * 32 + t2) * 32 + tid]; cst[tid] = s; }
            VM_WAIT();
            float rstd[8];
#pragma unroll
            for (int r = 0; r < 8; ++r) { float ss = 0.f;
#pragma unroll
                for (int j = 0; j < 4; ++j) ss += (v[r][j][0] * v[r][j][0] + v[r][j][1] * v[r][j][1]) + (v[r][j][2] * v[r][j][2] + v[r][j][3] * v[r][j][3]);
                rstd[r] = rsqrtf(wave_sum(ss) * (1.f / DM) + EPS); if (lane == 0) rstdv[wave * 8 + r] = rstd[r]; }
#pragma unroll
            for (int j = 0; j < 4; ++j) { const int k4 = lane + 64 * j; const f32x4 a = *(const LAS f32x4*)(tabA + 4 * k4), bb = *(const LAS f32x4*)(tabB + 4 * k4);
#pragma unroll
                for (int r = 0; r < 8; ++r) { const f32x4 h = v[r][j] * rstd[r] * a + bb; ((unsigned*)(H8 + (size_t)(rb * 64 + wave * 8 + r) * DM))[k4] = pack4_fp8(h[0], h[1], h[2], h[3]); } }
            f32x4 acc0 = {0.f, 0.f, 0.f, 0.f}, acc1 = {0.f, 0.f, 0.f, 0.f};
            const int fr = lane & 15, fq = lane >> 4;
            const int wsp = lane >> 3, wfq = (lane >> 1) & 3, wh8 = lane & 1, wfr0 = 8 * (wave & 1), wc = wfq | ((wsp & 1) ? 12 : 0);
            LAS unsigned char* wbase = XT + (((wave >> 1) * 8 + wsp) * 2) * 1024 + wfq * 256 + 8 * wh8;
            const LAS unsigned char* rbase_e = XT + (wave & 3) * 16384 + fq * 256 + (fr ^ fq) * 16;
            const LAS unsigned char* rbase_o = XT + (wave & 3) * 16384 + fq * 256 + (fr ^ (fq | 12)) * 16;
#pragma unroll
            for (int j = 0; j < 4; ++j) {
                __syncthreads();
#pragma unroll
                for (int r = 0; r < 8; ++r) { const f32x4 x = v[r][j];
                    u32x2 hi; hi.x = cvtpk(x[0], x[1]); hi.y = cvtpk(x[2], x[3]);
                    u32x2 lo; lo.x = cvtpk(x[0] - bf_lo(hi.x), x[1] - bf_hi(hi.x)); lo.y = cvtpk(x[2] - bf_lo(hi.y), x[3] - bf_hi(hi.y));
                    LAS unsigned char* p = wbase + ((wfr0 + r) ^ wc) * 16; *(LAS u32x2*)p = hi; *(LAS u32x2*)(p + 1024) = lo; }
                __syncthreads();
                if (wave < 4) {
#pragma unroll
                    for (int ks = 0; ks < 8; ++ks) { const LAS unsigned char* ap = ((ks & 1) ? rbase_o : rbase_e) + ks * 2048;
                        const bf16x8 ahi = *(const LAS bf16x8*)ap, alo = *(const LAS bf16x8*)(ap + 1024);
                        const bf16x8 b0 = *(const LAS bf16x8*)(WRA + (8 * j + ks) * 1024 + lane * 16), b1 = *(const LAS bf16x8*)(WRA + (32 + 8 * j + ks) * 1024 + lane * 16);
                        acc0 = __builtin_amdgcn_mfma_f32_16x16x32_bf16(ahi, b0, acc0, 0, 0, 0); acc0 = __builtin_amdgcn_mfma_f32_16x16x32_bf16(alo, b0, acc0, 0, 0, 0);
                        acc1 = __builtin_amdgcn_mfma_f32_16x16x32_bf16(ahi, b1, acc1, 0, 0, 0); acc1 = __builtin_amdgcn_mfma_f32_16x16x32_bf16(alo, b1, acc1, 0, 0, 0); }
                }
            }
            if (wave < 4) {
                const float c0 = cst[fr], c1 = cst[16 + fr];
#pragma unroll
                for (int reg = 0; reg < 4; ++reg) {
                    const int rl = 16 * wave + 4 * fq + reg; const float rs = rstdv[rl];
                    const float v0 = acc0[reg] * rs + c0, v1 = acc1[reg] * rs + c1;
                    int rank0 = (v1 > v0) ? 1 : 0, rank1 = (v0 >= v1) ? 1 : 0;
                    RankStep<1>::run(v0, v1, fr, rank0, rank1);
                    const bool sel0 = rank0 < 4, sel1 = rank1 < 4;
                    float m = fmaxf(v0, v1), ps;
                    m = fmaxf(m, dpp_ror_f<8>(m)); m = fmaxf(m, dpp_ror_f<4>(m)); m = fmaxf(m, dpp_ror_f<2>(m)); m = fmaxf(m, dpp_ror_f<1>(m));
                    const float p0 = sel0 ? __expf(v0 - m) : 0.f, p1 = sel1 ? __expf(v1 - m) : 0.f;
                    ps = p0 + p1;
                    ps += dpp_ror_f<8>(ps); ps += dpp_ror_f<4>(ps); ps += dpp_ror_f<2>(ps); ps += dpp_ror_f<1>(ps);
                    const float inv = 1.f / ps;
                    const unsigned g0 = (unsigned)(__ballot(sel0) >> (16 * fq)) & 0xffffu, g1 = (unsigned)(__ballot(sel1) >> (16 * fq)) & 0xffffu;
                    const unsigned below = (1u << fr) - 1u;
                    if (sel0) { const int k = __popc(g0 & below); const int rk = __hip_atomic_fetch_add(lcnt + fr, 1, __ATOMIC_RELAXED, __HIP_MEMORY_SCOPE_WORKGROUP);
                        asg_e[rl * 4 + k] = fr; asg_r[rl * 4 + k] = rk; asg_w[rl * 4 + k] = p0 * inv; }
                    if (sel1) { const int k = __popc(g0) + __popc(g1 & below); const int rk = __hip_atomic_fetch_add(lcnt + 16 + fr, 1, __ATOMIC_RELAXED, __HIP_MEMORY_SCOPE_WORKGROUP);
                        asg_e[rl * 4 + k] = 16 + fr; asg_r[rl * 4 + k] = rk; asg_w[rl * 4 + k] = p1 * inv; }
                }
            }
            __syncthreads();
            if (tid < 32) { const int n = lcnt[tid]; lbase[tid] = n ? (int)__hip_atomic_fetch_add(gcnt + 16 * tid, (unsigned)n, __ATOMIC_RELAXED, __HIP_MEMORY_SCOPE_AGENT) : 0; }
            __syncthreads();
            if (tid < 256) { const int e2 = asg_e[tid], rank = lbase[e2] + asg_r[tid], tok = rb * 64 + (tid >> 2);
                rowtok[(size_t)e2 * ECAP + rank] = tok; roww[(size_t)e2 * ECAP + rank] = asg_w[tid]; tokslot[tok * 4 + (tid & 3)] = (e2 << 16) | rank; }
            __syncthreads();
        }
    }
    xcd_barrier(bar);

    LAS int* ecnt = (LAS int*)(lds + MISC_OFF - 4096); LAS int* etile0 = ecnt + 32; LAS int* tile_e = etile0 + 33;
    if (tid < 64) {
        const int e = tid & 31; const int n = (int)__hip_atomic_load(gcnt + 16 * e, __ATOMIC_RELAXED, __HIP_MEMORY_SCOPE_AGENT); const int nt = (n + 255) >> 8;
        int inc = nt;
#pragma unroll
        for (int o = 1; o < 32; o <<= 1) { const int t2 = __shfl_up(inc, o, 32); if (e >= o) inc += t2; }
        const int base = inc - nt;
        if (tid < 32) { ecnt[e] = n; etile0[e] = base; for (int q = 0; q < nt; ++q) tile_e[base + q] = e; if (e == 31) etile0[NE] = inc; }
    }
    __syncthreads();
    const int MT = etile0[NE];

    {
        const int tid = opaque_tid(), lane = tid & 63, wave = __builtin_amdgcn_readfirstlane(tid >> 6), gw = bid * NWAVES + wave; (void)lane; (void)gw;
        LAS unsigned short* tokl = (LAS unsigned short*)(lds + 131072);
        MoeOrder<true> S; S.init(MT, 8, DM, G, bid, tile_e, tokl);
        { Unit u; for (int i = 0; S.next(i, u); ++i) { if (tid < 256) { const int e = u.pn >> 3, lt = u.pm - etile0[e], rank = lt * 256 + tid; tokl[i * 256 + tid] = (unsigned short)((rank < ecnt[e]) ? rowtok[(size_t)e * ECAP + rank] : 0); } } }
        __syncthreads();
        EpiGate E{ACT8, A.b_gate_up};
        gemm_phase_f8<EpiGate, MoeOrder<true>, true>(lds, H8, Wgu8, DM, S, E);
    }
    xcd_barrier(bar);

    {
        const int tid = opaque_tid(), lane = tid & 63, wave = __builtin_amdgcn_readfirstlane(tid >> 6), gw = bid * NWAVES + wave; (void)lane; (void)gw;
        MoeOrder<false> S; S.init(MT, 4, DE, G, bid, tile_e, nullptr);
        EpiDown E{Y8, A.b_down, roww, ecnt, etile0};
        gemm_phase_f8<EpiDown, MoeOrder<false>, true>(lds, ACT8, Wd8, DE, S, E);
    }
    xcd_barrier(bar);

    {
        const int tid = opaque_tid(), lane = tid & 63, wave = __builtin_amdgcn_readfirstlane(tid >> 6), gw = bid * NWAVES + wave; (void)lane; (void)gw;
        for (int rg = gw; rg < T / 8; rg += NGW) {
            const int r0 = rg * 8, b = r0 / SEQ;
            int slotv = 0;
            if (lane < 32) { const int ts = tokslot[r0 * 4 + lane]; slotv = etile0[ts >> 16] * 256 + (ts & 0xffff); }
            f32x4 g2v[2][2];
#pragma unroll
            for (int j = 0; j < 2; ++j) { g2v[j][0] = *(const f32x4*)(modf + (size_t)b * NMOD + 5 * DM + 512 * j + 8 * lane) * (1.f / YSCALE); g2v[j][1] = *(const f32x4*)(modf + (size_t)b * NMOD + 5 * DM + 512 * j + 8 * lane + 4) * (1.f / YSCALE); }
#pragma unroll 1
            for (int p = 0; p < 4; ++p) {
                u32x2 yw[2][4][2]; f32x4 xv[2][2][2];
#pragma unroll
                for (int r = 0; r < 2; ++r) { const int row = r0 + 2 * p + r;
#pragma unroll
                    for (int k = 0; k < 4; ++k) { const int sl = __shfl(slotv, 4 * (2 * p + r) + k);
#pragma unroll
                        for (int j = 0; j < 2; ++j) yw[r][k][j] = __builtin_nontemporal_load((const u32x2*)(Y8 + (size_t)sl * DM + 512 * j + 8 * lane)); }
#pragma unroll
                    for (int j = 0; j < 2; ++j) { const size_t oo = (size_t)row * DM + 512 * j + 8 * lane; const u32x4 dv = __builtin_nontemporal_load((const u32x4*)(DELTAb + oo));
                        xv[r][j][0] = __builtin_nontemporal_load((const f32x4*)(A.x + oo)) + (f32x4){bf_lo(dv.x), bf_hi(dv.x), bf_lo(dv.y), bf_hi(dv.y)};
                        xv[r][j][1] = __builtin_nontemporal_load((const f32x4*)(A.x + oo + 4)) + (f32x4){bf_lo(dv.z), bf_hi(dv.z), bf_lo(dv.w), bf_hi(dv.w)}; } }
#pragma unroll
                for (int r = 0; r < 2; ++r) { const int row = r0 + 2 * p + r;
#pragma unroll
                    for (int j = 0; j < 2; ++j) { float s[8] = {0.f, 0.f, 0.f, 0.f, 0.f, 0.f, 0.f, 0.f};
#pragma unroll
                        for (int k = 0; k < 4; ++k) { const u32x2 w = yw[r][k][j];
                            const f32x2 a0 = __builtin_amdgcn_cvt_pk_f32_fp8((int)w.x, false), a1 = __builtin_amdgcn_cvt_pk_f32_fp8((int)w.x, true), a2 = __builtin_amdgcn_cvt_pk_f32_fp8((int)w.y, false), a3 = __builtin_amdgcn_cvt_pk_f32_fp8((int)w.y, true);
                            s[0] += a0[0]; s[1] += a0[1]; s[2] += a1[0]; s[3] += a1[1]; s[4] += a2[0]; s[5] += a2[1]; s[6] += a3[0]; s[7] += a3[1]; }
                        float* op = A.out + (size_t)row * DM + 512 * j + 8 * lane;
                        __builtin_nontemporal_store(xv[r][j][0] + g2v[j][0] * (f32x4){s[0], s[1], s[2], s[3]}, (f32x4*)op); __builtin_nontemporal_store(xv[r][j][1] + g2v[j][1] * (f32x4){s[4], s[5], s[6], s[7]}, (f32x4*)(op + 4)); } }
            }
        }
    }
}

extern "C" void kernel_launch(void* const* d_in, const int* in_sizes, int n_in, void* d_out, int out_size, void* d_ws, size_t ws_size, hipStream_t stream) {
    static int grid = 0;
    if (grid == 0) {
        if (n_in != 20 || out_size != T * DM || ws_size < WS_END) { fprintf(stderr, "kernel_launch: unexpected problem shape (n_in %d out %d ws %zu)\n", n_in, out_size, ws_size); grid = -1; return; }
        int dev = 0, cus = 0;
        if (hipGetDevice(&dev) != hipSuccess || hipDeviceGetAttribute(&cus, hipDeviceAttributeMultiprocessorCount, dev) != hipSuccess) { grid = -1; return; }
        if (hipFuncSetAttribute((const void*)fwd_kernel, hipFuncAttributeMaxDynamicSharedMemorySize, LDS_BYTES) != hipSuccess) { fprintf(stderr, "kernel_launch: hipFuncSetAttribute failed\n"); grid = -1; return; }
        int per_cu = 0;
        if (hipOccupancyMaxActiveBlocksPerMultiprocessor(&per_cu, (const void*)fwd_kernel, NTHR, LDS_BYTES) != hipSuccess || per_cu < 1) { fprintf(stderr, "kernel_launch: occupancy query says %d\n", per_cu); }
        (void)hipGetLastError();
        grid = cus;
    }
    if (grid < 0) return;
    if (hipMemsetAsync((char*)d_ws + WS_CTL, 0, CTL_ZERO_BYTES, stream) != hipSuccess) return;
    Args a{};
    a.x = (const float*)d_in[0]; a.c = (const float*)d_in[1]; a.w_ada = (const float*)d_in[2]; a.b_ada = (const float*)d_in[3]; a.norm1_w = (const float*)d_in[4];
    a.w_in = (const float*)d_in[5]; a.b_forget = (const float*)d_in[6]; a.q_norm_w = (const float*)d_in[7]; a.k_norm_w = (const float*)d_in[8]; a.conv_w = (const float*)d_in[9];
    a.attn_out_norm_w = (const float*)d_in[10]; a.conv_out_norm_w = (const float*)d_in[11]; a.w_out = (const float*)d_in[12]; a.norm2_w = (const float*)d_in[13];
    a.w_router = (const float*)d_in[14]; a.b_router = (const float*)d_in[15]; a.w_gate_up = (const float*)d_in[16]; a.b_gate_up = (const float*)d_in[17];
    a.w_down = (const float*)d_in[18]; a.b_down = (const float*)d_in[19];
    a.out = (float*)d_out; a.ws = (unsigned char*)d_ws;
    hipLaunchKernelGGL(fwd_kernel, dim3(grid), dim3(NTHR), LDS_BYTES, stream, a);
}
```

```cpp
#include <hip/hip_runtime.h>
#include <cstdint>
#include <cstdio>


#define GAS __attribute__((address_space(1)))
#define LAS __attribute__((address_space(3)))
typedef unsigned short bf16;
typedef short bf16x8 __attribute__((ext_vector_type(8)));
typedef float f32x4 __attribute__((ext_vector_type(4)));
typedef float f32x2 __attribute__((ext_vector_type(2)));
typedef unsigned u32x4 __attribute__((ext_vector_type(4)));
typedef unsigned u32x2 __attribute__((ext_vector_type(2)));
typedef __bf16 bf16x2_t __attribute__((ext_vector_type(2)));

constexpr int NB = 8, SEQ = 2048, DM = 1024, T = NB * SEQ;
constexpr int DA = 512, DC = 512, NH = 8, HD = 64;
constexpr int NE = 32, TOPK = 4, DE = 1024;
constexpr int NIN = 3080, NMOD = 6 * DM;
constexpr int COL_F = 1536, COL_GB = 1544, COL_GC = 2056, COL_U = 2568;
constexpr float EPS = 1e-6f, LOG2E = 1.4426950408889634f;
constexpr float C2 = 0.125f * LOG2E;
constexpr int NWAVES = 8, NTHR = 512;
constexpr int ECAP = T;
constexpr int MAXMT = T * TOPK / 256 + NE;

constexpr size_t MiB = 1u << 20;
constexpr size_t WS_CTL = 0, CTL_ZERO_BYTES = 128 * 1024;
constexpr size_t WS_MODP = 1 * MiB;
constexpr size_t WS_LC = 2 * MiB;
constexpr size_t WS_TOT = WS_LC + 512 * 1024;
constexpr size_t WS_MODF = 3 * MiB;
constexpr size_t WS_WFC = 3 * MiB + 512 * 1024;
constexpr size_t WS_WRA = 12 * MiB;
constexpr size_t WS_CSTP = 13 * MiB;
constexpr size_t WS_WIN = 4 * MiB;
constexpr size_t WS_WOUT = 10 * MiB;
constexpr size_t WS_WGU = 16 * MiB;
constexpr size_t WS_WD = 144 * MiB;
constexpr size_t WS_H = 208 * MiB;
constexpr size_t WS_Q = 240 * MiB, WS_K = 256 * MiB, WS_V = 272 * MiB;
constexpr size_t WS_GB = 288 * MiB, WS_CU = 304 * MiB;
constexpr size_t WS_MIX = 320 * MiB;
constexpr size_t WS_TOKSLOT = 352 * MiB;
constexpr size_t WS_ROWTOK = 353 * MiB;
constexpr size_t WS_ROWW = 356 * MiB;
constexpr size_t WS_ACT = 360 * MiB;
constexpr size_t WS_Y = 504 * MiB;
constexpr size_t WS_O = 648 * MiB;
constexpr size_t WS_END = 664 * MiB;
constexpr int CW_BAR = 4096;
constexpr int CW_CNT = 16384;

constexpr int LDS_BYTES = 147456;
constexpr int MISC_OFF = LDS_BYTES - 512;

#define LDS_WAIT() asm volatile("s_waitcnt lgkmcnt(0)" ::: "memory")
#define VM_WAIT() asm volatile("s_waitcnt vmcnt(0)" ::: "memory")

__device__ __forceinline__ unsigned cvtpk(float lo, float hi) { f32x2 v = {lo, hi}; bf16x2_t b = __builtin_convertvector(v, bf16x2_t); return __builtin_bit_cast(unsigned, b); }
__device__ __forceinline__ float bf_lo(unsigned w) { return __uint_as_float(w << 16); }
__device__ __forceinline__ float bf_hi(unsigned w) { return __uint_as_float(w & 0xffff0000u); }

#define XB_TMO      128
#define XB_XCNT(j)  (256  + 64 * (j))
#define XB_XSUB(j)  (1280 + 64 * (j))
#define XB_XGEN(j)  (2304 + 64 * (j))
#define XB_TOP      3328
#define XB_TOPGEN   3392
#define XCD_BAR_WORDS 3456
#define XB_SPIN_CAP (1u << 18)

__device__ __forceinline__ unsigned xb_ld(unsigned* p)              { return __hip_atomic_load(p, __ATOMIC_RELAXED, __HIP_MEMORY_SCOPE_AGENT); }
__device__ __forceinline__ unsigned xb_add(unsigned* p, unsigned v) { return __hip_atomic_fetch_add(p, v, __ATOMIC_RELAXED, __HIP_MEMORY_SCOPE_AGENT); }
__device__ __forceinline__ unsigned xb_xcc_id() { return (unsigned)__builtin_amdgcn_s_getreg((3 << 11) | 20) & 0xFu; }
#define XB_SPIN(cond, bar) do { unsigned _sp = 0; while (cond) { __builtin_amdgcn_s_sleep(1); \
    if ((++_sp & 255u) == 0u) { if (xb_ld(&(bar)[XB_TMO])) break; if (_sp > XB_SPIN_CAP) { atomicAdd(&(bar)[XB_TMO], 1u); break; } } } } while (0)

struct XcdBarrier { unsigned* bar; unsigned x; volatile LAS unsigned* st; };

__device__ __forceinline__ XcdBarrier xcd_barrier_post(unsigned* bar, volatile LAS unsigned* st) {
    XcdBarrier b; b.bar = bar; b.x = xb_xcc_id(); b.st = st;
    if (threadIdx.x == 0) (void)xb_add(&bar[XB_XCNT(b.x)], 1u);
    return b;
}
__device__ __forceinline__ void xcd_barrier_complete(unsigned* bar, unsigned x, unsigned& nloc, unsigned& nx) {
    const unsigned G = gridDim.x * gridDim.y * gridDim.z;
    unsigned sum, cnt, mine, sp = 0u;
    for (;;) {
        sum = 0u; cnt = 0u; mine = 0u;
#pragma unroll
        for (unsigned j = 0; j < 16; ++j) { const unsigned c = xb_ld(&bar[XB_XCNT(j)]); sum += c; cnt += (c > 0u) ? 1u : 0u; mine = (j == x) ? c : mine; }
        if (sum == G) break;
        __builtin_amdgcn_s_sleep(1);
        if ((++sp & 255u) == 0u) { if (xb_ld(&bar[XB_TMO])) break; if (sp > XB_SPIN_CAP) { atomicAdd(&bar[XB_TMO], 1u); break; } }
    }
    nloc = mine > 0u ? mine : 1u; nx = cnt > 0u ? cnt : 1u;
}
__device__ __forceinline__ void xcd_barrier(const XcdBarrier& b) {
    asm volatile("s_waitcnt vmcnt(0)" ::: "memory");
    __syncthreads();
    if (threadIdx.x == 0) {
        unsigned* bar = b.bar;
        __builtin_amdgcn_s_waitcnt(0);
        unsigned nloc = b.st[0], nx = b.st[1];
        if (nloc == 0u) { xcd_barrier_complete(bar, b.x, nloc, nx); b.st[0] = nloc; b.st[1] = nx; }
        const unsigned old = xb_add(&bar[XB_XSUB(b.x)], 1u);
        const unsigned gen = old / nloc;
        if (old + 1u == (gen + 1u) * nloc) {
            __builtin_amdgcn_fence(__ATOMIC_RELEASE, "agent");
            asm volatile("s_waitcnt vmcnt(0)" ::: "memory");
            const unsigned og = xb_add(&bar[XB_TOP], 1u);
            const unsigned tg = og / nx;
            if (og + 1u == (tg + 1u) * nx) xb_add(&bar[XB_TOPGEN], 1u);
            else XB_SPIN(xb_ld(&bar[XB_TOPGEN]) == tg, bar);
            __builtin_amdgcn_fence(__ATOMIC_ACQUIRE, "agent");
            xb_add(&bar[XB_XGEN(b.x)], 1u);
            asm volatile("s_waitcnt vmcnt(0)" ::: "memory");
        } else {
            XB_SPIN(xb_ld(&bar[XB_XGEN(b.x)]) == gen, bar);
            __builtin_amdgcn_fence(__ATOMIC_ACQUIRE, "agent");
            asm volatile("s_waitcnt vmcnt(0)" ::: "memory");
        }
    }
    __syncthreads();
}

__device__ __forceinline__ void store16_wt(void* p, u32x4 v) { asm volatile("global_store_dwordx4 %0, %1, off sc1\n\ts_nop 1" :: "v"(p), "v"(v) : "memory"); }
__device__ __forceinline__ int opaque_tid() { int t = threadIdx.x; asm volatile("" : "+v"(t)); return t; }
__device__ __forceinline__ float wave_sum(float v) {
#pragma unroll
    for (int o = 1; o < 64; o <<= 1) v += __shfl_xor(v, o);
    return v;
}
__device__ __forceinline__ float siluf(float v) { return v / (1.f + __expf(-v)); }

struct Args {
    const float* x; const float* c; const float* w_ada; const float* b_ada; const float* norm1_w; const float* w_in; const float* b_forget;
    const float* q_norm_w; const float* k_norm_w; const float* conv_w; const float* attn_out_norm_w; const float* conv_out_norm_w; const float* w_out;
    const float* norm2_w; const float* w_router; const float* b_router; const float* w_gate_up; const float* b_gate_up; const float* w_down; const float* b_down;
    float* out; unsigned char* ws;
};

struct TItem { const float* src; bf16* dst; int ldw, K; };
__device__ __forceinline__ void titem_load(const TItem& t, int lane, f32x4 (&v)[8]) {
#pragma unroll
    for (int i = 0; i < 8; ++i) v[i] = __builtin_nontemporal_load((const f32x4*)(t.src + (size_t)(16 * (i >> 1) + 2 * (lane >> 3) + (i & 1)) * t.ldw + 4 * (lane & 7)));
}
__device__ __forceinline__ void titem_store(const TItem& t, int lane, const f32x4 (&v)[8], LAS unsigned* scr) {
#pragma unroll
    for (int ip = 0; ip < 4; ++ip) { const int kp = 8 * ip + (lane >> 3);
#pragma unroll
        for (int j = 0; j < 4; ++j) scr[(4 * (lane & 7) + j) * 33 + kp] = cvtpk(v[2 * ip][j], v[2 * ip + 1][j]); }
    LDS_WAIT(); asm volatile("" ::: "memory");
#pragma unroll
    for (int p = 0; p < 4; ++p) { const int n = (lane >> 3) + 8 * p, c = lane & 7; const LAS unsigned* s = scr + n * 33 + 4 * c;
        u32x4 o; o.x = s[0]; o.y = s[1]; o.z = s[2]; o.w = s[3];
        *(u32x4*)(t.dst + (size_t)n * t.K + 8 * c) = o; }
    LDS_WAIT(); asm volatile("" ::: "memory");
}

constexpr float YSCALE = 32.f;
constexpr float WSCALE = 64.f;
typedef int v8i __attribute__((ext_vector_type(8)));
__device__ __forceinline__ unsigned pack4_fp8(float a, float b, float c, float d) { unsigned w = __builtin_amdgcn_cvt_pk_fp8_f32(a, b, 0u, false); return __builtin_amdgcn_cvt_pk_fp8_f32(c, d, w, true); }
struct TItem8 { const float* src; unsigned char* dst; int ldw, K; };
__device__ __forceinline__ void titem8_load(const TItem8& t, int lane, f32x4 (&v)[16]) {
#pragma unroll
    for (int i = 0; i < 16; ++i) v[i] = __builtin_nontemporal_load((const f32x4*)(t.src + (size_t)(32 * (i >> 2) + 4 * (lane >> 3) + (i & 3)) * t.ldw + 4 * (lane & 7)));
}
__device__ __forceinline__ void titem8_store(const TItem8& t, int lane, const f32x4 (&v)[16], LAS unsigned* scr) {
#pragma unroll
    for (int q = 0; q < 4; ++q) { const int kq = 8 * q + (lane >> 3);
#pragma unroll
        for (int j = 0; j < 4; ++j) scr[(4 * (lane & 7) + j) * 33 + kq] = pack4_fp8(v[4 * q][j] * WSCALE, v[4 * q + 1][j] * WSCALE, v[4 * q + 2][j] * WSCALE, v[4 * q + 3][j] * WSCALE); }
    LDS_WAIT(); asm volatile("" ::: "memory");
#pragma unroll
    for (int p = 0; p < 4; ++p) { const int n = (lane >> 3) + 8 * p, c = lane & 7; const LAS unsigned* s = scr + n * 33 + 4 * c;
        u32x4 o; o.x = s[0]; o.y = s[1]; o.z = s[2]; o.w = s[3];
        __builtin_nontemporal_store(o, (u32x4*)(t.dst + (size_t)n * t.K + 16 * c)); }
    LDS_WAIT(); asm volatile("" ::: "memory");
}

__device__ __forceinline__ int win_src_col(int g) {
    const int pn = g >> 3, p0 = (g & 7) * 32, bj = p0 >> 7, wc = (p0 >> 5) & 3;
    if (pn < 2) return 256 * pn + 64 * wc + 32 * bj;
    if (pn < 4) return 512 + 256 * (pn - 2) + 64 * wc + 32 * bj;
    if (pn < 6) return 1024 + 256 * (pn - 4) + p0;
    if (pn < 8) return COL_GB + 256 * (pn - 6) + p0;
    return (bj ? COL_U : COL_GC) + 128 * (pn - 8) + 32 * wc;
}

namespace pg8 {
constexpr int BM = 256, BK = 64, HALF = 128, HTB = HALF * BK * 2, STAGE_BYTES = 8 * HTB;
__device__ __forceinline__ int lds_byte(int r, int c) { const int st = (r >> 4) * 2 + (c >> 5), rr = r & 15, cc = c & 31, ob = rr * 64 + cc * 2; return st * 1024 + (ob ^ (((ob >> 9) & 1) << 5)); }
__device__ __forceinline__ void stage_rc(int b, int& R, int& C) { const int st = b / 1024, sb = b % 1024, swz = sb ^ (((sb >> 9) & 1) << 5); R = (st >> 1) * 16 + swz / 64; C = (st & 1) * 32 + (swz % 64) / 2; }
__device__ __forceinline__ int perm32(int rho) { const int n = rho >> 4, i = rho & 15; return 8 * (i >> 2) + 4 * n + (i & 3); }
}
struct Unit { int pm, pn; };

template <class Epi, class Sched, bool ALIGN_EPI>
__device__ __forceinline__ void gemm_phase(LAS unsigned char* lds, const bf16* A, const bf16* Bt, const int K, const Sched& S, const Epi& E) {
    using namespace pg8;
    const int tid = opaque_tid(), wid = __builtin_amdgcn_readfirstlane(tid >> 6), lane = tid & 63, wr = wid >> 2, wc = wid & 3, fr = lane & 15, fq = lane >> 4;
    const int nt = K / BK;
    int Ra[2]; unsigned Ca2[2], voffB[2];
#pragma unroll
    for (int i = 0; i < 2; ++i) { int R, C; stage_rc(tid * 16 + i * 8192, R, C); const int Rb = (R & ~31) + perm32(R & 31); Ra[i] = R; Ca2[i] = (unsigned)C * 2u; voffB[i] = (unsigned)(Rb * K + C) * 2u; }
    const size_t kstep = (size_t)(BK * 2), hstep = (size_t)HALF * K * 2, tstep = 2 * hstep;
    const unsigned ldsw = (unsigned)wid * 1024u;
    LAS unsigned char* ldsA = lds + lds_byte(wr * 64 + fr, fq * 8); LAS unsigned char* ldsB = lds + 4 * HTB + lds_byte(wc * 32 + fr, fq * 8);
    asm volatile("" : "+v"(ldsA)); asm volatile("" : "+v"(ldsB));
#define PG8_SA(b, h) (((b) * 2 + (h)) * HTB)
#define PG8_SB(b, h) ((4 + (b) * 2 + (h)) * HTB)
#define PG8_STAGE_B(bufoff, gbase) do { _Pragma("unroll") for (int _i = 0; _i < 2; ++_i) \
        __builtin_amdgcn_global_load_lds((const unsigned*)((const char*)(gbase) + voffB[_i]), (LAS unsigned*)(lds + (bufoff) + ldsw + _i * 8192), 16, 0, 0); } while (0)
#define PG8_STAGE_A(bufoff, kbytes, off, h) do { _Pragma("unroll") for (int _i = 0; _i < 2; ++_i) \
        __builtin_amdgcn_global_load_lds((const unsigned*)((const char*)A + (kbytes) + off[h][_i]), (LAS unsigned*)(lds + (bufoff) + ldsw + _i * 8192), 16, 0, 0); } while (0)
#define PG8_LDA(dst, b, h) do { _Pragma("unroll") for (int m = 0; m < 4; ++m) _Pragma("unroll") for (int k = 0; k < 2; ++k) dst[m][k] = *(const LAS bf16x8*)(ldsA + PG8_SA(b, h) + m * 2048 + k * 1024); } while (0)
#define PG8_LDB(dst, b, h) do { _Pragma("unroll") for (int n = 0; n < 2; ++n) _Pragma("unroll") for (int k = 0; k < 2; ++k) dst[n][k] = *(const LAS bf16x8*)(ldsB + PG8_SA(b, h) + n * 2048 + k * 1024); } while (0)
#define PG8_MMA(ai, bj, At, Bt_) do { __builtin_amdgcn_s_setprio(1); _Pragma("unroll") for (int m = 0; m < 4; ++m) _Pragma("unroll") for (int n = 0; n < 2; ++n) _Pragma("unroll") for (int k = 0; k < 2; ++k) \
        acc[ai][bj][m][n] = __builtin_amdgcn_mfma_f32_16x16x32_bf16(Bt_[n][k], At[m][k], acc[ai][bj][m][n], 0, 0, 0); __builtin_amdgcn_s_setprio(0); } while (0)
#define PG8_WAIT_V(n) asm volatile("s_waitcnt vmcnt(" #n ")" ::: "memory")
#define PG8_WAIT_L(n) asm volatile("s_waitcnt lgkmcnt(" #n ")" ::: "memory")
#define PG8_BAR __builtin_amdgcn_s_barrier()
#define PG8_SCHED __builtin_amdgcn_sched_barrier(0)
    Unit cur, nxt; int ui = 0;
    if (!S.next(0, cur)) return;
    f32x4 acc[2][2][4][2];
#pragma unroll
    for (int a = 0; a < 2; ++a)
#pragma unroll
        for (int b = 0; b < 2; ++b)
#pragma unroll
            for (int m = 0; m < 4; ++m)
#pragma unroll
                for (int n = 0; n < 2; ++n) acc[a][b][m][n] = (f32x4){0.f, 0.f, 0.f, 0.f};
    bf16x8 At[4][2], B0[2][2], B1[2][2];
    LAS float* epi = (LAS float*)(lds + 136192 + wid * 768);
    unsigned coff[2][2], noff[2][2];
#pragma unroll
    for (int h = 0; h < 2; ++h)
#pragma unroll
        for (int i = 0; i < 2; ++i) coff[h][i] = S.a_off(0, cur, HALF * h + Ra[i]) + Ca2[i];
    const char* cB = (const char*)Bt + (size_t)cur.pn * tstep;
    PG8_STAGE_B(PG8_SB(0, 0), cB); PG8_STAGE_B(PG8_SB(0, 1), cB + hstep); PG8_STAGE_A(PG8_SA(0, 0), 0, coff, 0); PG8_STAGE_A(PG8_SA(0, 1), 0, coff, 1);
    if (wr == 1) PG8_BAR;
    PG8_WAIT_V(2); PG8_BAR;
    PG8_STAGE_B(PG8_SB(1, 0), cB + kstep); PG8_STAGE_A(PG8_SA(1, 0), kstep, coff, 0); PG8_STAGE_B(PG8_SB(1, 1), cB + hstep + kstep);
    PG8_WAIT_V(6); PG8_BAR;
    for (;;) {
        const bool has_next = S.next(ui + 1, nxt);
#pragma unroll
        for (int h = 0; h < 2; ++h)
#pragma unroll
            for (int i = 0; i < 2; ++i) noff[h][i] = has_next ? (S.a_off(ui + 1, nxt, HALF * h + Ra[i]) + Ca2[i]) : coff[h][i];
        const char* nB = has_next ? (const char*)Bt + (size_t)nxt.pn * tstep : cB;
#pragma unroll 1
        for (int t = 0; t < nt; t += 2) {
            const bool last = (t == nt - 2);
            const size_t k1 = (size_t)(t + 1) * kstep;
            const size_t k2 = last ? 0 : (size_t)(t + 2) * kstep, k3 = k2 + kstep;
            const char* b2 = last ? nB : cB + (size_t)(t + 2) * kstep; const char* b3 = b2 + kstep;
            unsigned o2[2][2];
#pragma unroll
            for (int h = 0; h < 2; ++h)
#pragma unroll
                for (int i = 0; i < 2; ++i) o2[h][i] = last ? noff[h][i] : coff[h][i];
            if (last) E.prefetch(cur, wr, wc, lane, epi);
            PG8_LDB(B0, 0, 0); PG8_LDB(B1, 0, 1); PG8_SCHED; PG8_LDA(At, 0, 0); PG8_STAGE_A(PG8_SA(1, 1), k1, coff, 1);
            PG8_WAIT_V(8); PG8_WAIT_L(0); PG8_BAR; PG8_MMA(0, 0, At, B0); PG8_MMA(0, 1, At, B1); PG8_BAR; PG8_SCHED;
            PG8_LDA(At, 0, 1); PG8_STAGE_B(PG8_SB(0, 0), b2); PG8_STAGE_B(PG8_SB(0, 1), b2 + hstep); PG8_STAGE_A(PG8_SA(0, 0), k2, o2, 0);
            PG8_WAIT_V(8); PG8_WAIT_L(0); PG8_BAR; PG8_MMA(1, 0, At, B0); PG8_MMA(1, 1, At, B1); PG8_BAR; PG8_SCHED;
            PG8_LDB(B0, 1, 0); PG8_LDB(B1, 1, 1); PG8_SCHED; PG8_LDA(At, 1, 0); PG8_STAGE_A(PG8_SA(0, 1), k2, o2, 1);
            PG8_WAIT_V(8); PG8_WAIT_L(0); PG8_BAR; PG8_MMA(0, 0, At, B0); PG8_MMA(0, 1, At, B1); PG8_BAR; PG8_SCHED;
            PG8_LDA(At, 1, 1); PG8_STAGE_B(PG8_SB(1, 0), b3); PG8_STAGE_B(PG8_SB(1, 1), b3 + hstep); PG8_STAGE_A(PG8_SA(1, 0), k3, o2, 0);
            PG8_WAIT_V(8); PG8_WAIT_L(0); PG8_BAR; PG8_MMA(1, 0, At, B0); PG8_MMA(1, 1, At, B1); PG8_BAR; PG8_SCHED;
        }
        if constexpr (ALIGN_EPI) { if (wr == 0) PG8_BAR; }
        E(acc, cur, wr, wc, fr, fq, (const LAS float*)epi);
        if (!has_next) break;
#pragma unroll
        for (int a = 0; a < 2; ++a)
#pragma unroll
            for (int b = 0; b < 2; ++b)
#pragma unroll
                for (int m = 0; m < 4; ++m)
#pragma unroll
                    for (int n = 0; n < 2; ++n) acc[a][b][m][n] = (f32x4){0.f, 0.f, 0.f, 0.f};
        cur = nxt; cB = nB; ++ui;
#pragma unroll
        for (int h = 0; h < 2; ++h)
#pragma unroll
            for (int i = 0; i < 2; ++i) coff[h][i] = noff[h][i];
        if constexpr (ALIGN_EPI) { if (wr == 1) PG8_BAR; }
    }
    PG8_WAIT_V(0);
    if constexpr (!ALIGN_EPI) { if (wr == 0) PG8_BAR; }
    PG8_BAR;
#undef PG8_SA
#undef PG8_SB
#undef PG8_STAGE_A
#undef PG8_STAGE_B
#undef PG8_LDA
#undef PG8_LDB
#undef PG8_MMA
#undef PG8_WAIT_V
#undef PG8_WAIT_L
#undef PG8_BAR
#undef PG8_SCHED
}

template <class Epi, class Sched, bool ALIGN_EPI>
__device__ __forceinline__ void gemm_phase_f8(LAS unsigned char* lds, const unsigned char* A, const unsigned char* Bt, const int K, const Sched& S, const Epi& E) {
    using namespace pg8;
    const int tid = opaque_tid(), wid = __builtin_amdgcn_readfirstlane(tid >> 6), lane = tid & 63, wr = wid >> 2, wc = wid & 3, fr = lane & 15, fq = lane >> 4;
    const int nt = K / 128;
    const __amdgpu_buffer_rsrc_t rsA = __builtin_amdgcn_make_buffer_rsrc((void*)A, 0, 0x7fffffff, 0x00020000), rsB = __builtin_amdgcn_make_buffer_rsrc((void*)Bt, 0, 0x7fffffff, 0x00020000);
    int Ra[2]; unsigned Ca2[2], voffB[2];
#pragma unroll
    for (int i = 0; i < 2; ++i) { const int p = wid + 8 * i, R = 16 * (p >> 1) + fr, C = 64 * (p & 1) + 16 * fq; const int Rb = (R & ~31) + perm32(R & 31); Ra[i] = R; Ca2[i] = (unsigned)C; voffB[i] = (unsigned)(Rb * K + C); }
    const unsigned kstep = 128, hstep = (unsigned)HALF * K, tstep = 2 * hstep;
    const unsigned ldsw = (unsigned)wid * 1024u;
    LAS unsigned char* ldsA = lds + wr * 8192 + lane * 16; LAS unsigned char* ldsB = lds + 4 * HTB + wc * 4096 + lane * 16;
    asm volatile("" : "+v"(ldsA)); asm volatile("" : "+v"(ldsB));
#define PG8_SA(b, h) (((b) * 2 + (h)) * HTB)
#define PG8_SB(b, h) ((4 + (b) * 2 + (h)) * HTB)
#define PG8_STAGE_B(bufoff, soff) do { _Pragma("unroll") for (int _i = 0; _i < 2; ++_i) \
        __builtin_amdgcn_raw_ptr_buffer_load_lds(rsB, (LAS unsigned*)(lds + (bufoff) + ldsw + _i * 8192), 16, voffB[_i], (soff), 0, 0); } while (0)
#define PG8_STAGE_A(bufoff, soff, h) do { _Pragma("unroll") for (int _i = 0; _i < 2; ++_i) \
        __builtin_amdgcn_raw_ptr_buffer_load_lds(rsA, (LAS unsigned*)(lds + (bufoff) + ldsw + _i * 8192), 16, coff[h][_i], (soff), 0, 0); } while (0)
#define PG8_LD32(dst, ptr) do { const u32x4 lo_ = *(const LAS u32x4*)(ptr), hi_ = *(const LAS u32x4*)((ptr) + 1024); dst = (v8i){(int)lo_.x, (int)lo_.y, (int)lo_.z, (int)lo_.w, (int)hi_.x, (int)hi_.y, (int)hi_.z, (int)hi_.w}; } while (0)
#define PG8_LDA(dst, b, h) do { _Pragma("unroll") for (int m = 0; m < 4; ++m) PG8_LD32(dst[m], ldsA + PG8_SA(b, h) + m * 2048); } while (0)
#define PG8_LDB(dst, b, h) do { _Pragma("unroll") for (int n = 0; n < 2; ++n) PG8_LD32(dst[n], ldsB + PG8_SA(b, h) + n * 2048); } while (0)
#define PG8_MMA(ai, bj, At, Bt_) do { __builtin_amdgcn_s_setprio(1); _Pragma("unroll") for (int m = 0; m < 4; ++m) _Pragma("unroll") for (int n = 0; n < 2; ++n) \
        acc[ai][bj][m][n] = __builtin_amdgcn_mfma_scale_f32_16x16x128_f8f6f4(Bt_[n], At[m], acc[ai][bj][m][n], 0, 0, 0, 0, 0, 0); __builtin_amdgcn_s_setprio(0); } while (0)
#define PG8_WAIT_V(n) asm volatile("s_waitcnt vmcnt(" #n ")" ::: "memory")
#define PG8_WAIT_L(n) asm volatile("s_waitcnt lgkmcnt(" #n ")" ::: "memory")
#define PG8_BAR __builtin_amdgcn_s_barrier()
#define PG8_SCHED __builtin_amdgcn_sched_barrier(0)
    Unit cur, nxt; int ui = 0;
    if (!S.next(0, cur)) return;
    f32x4 acc[2][2][4][2];
#pragma unroll
    for (int a = 0; a < 2; ++a)
#pragma unroll
        for (int b = 0; b < 2; ++b)
#pragma unroll
            for (int m = 0; m < 4; ++m)
#pragma unroll
                for (int n = 0; n < 2; ++n) acc[a][b][m][n] = (f32x4){0.f, 0.f, 0.f, 0.f};
    v8i At[4], B0[2], B1[2];
    LAS float* epi = (LAS float*)(lds + 136192 + wid * 768);
    unsigned coff[2][2];
#pragma unroll
    for (int h = 0; h < 2; ++h)
#pragma unroll
        for (int i = 0; i < 2; ++i) coff[h][i] = S.a_off(0, cur, HALF * h + Ra[i]) + Ca2[i];
    unsigned cB = (unsigned)cur.pn * tstep;
    PG8_STAGE_B(PG8_SB(0, 0), cB); PG8_STAGE_B(PG8_SB(0, 1), cB + hstep); PG8_STAGE_A(PG8_SA(0, 0), 0u, 0); PG8_STAGE_A(PG8_SA(0, 1), 0u, 1);
    if (wr == 1) PG8_BAR;
    PG8_WAIT_V(2); PG8_BAR;
    PG8_STAGE_B(PG8_SB(1, 0), cB + kstep); PG8_STAGE_A(PG8_SA(1, 0), kstep, 0); PG8_STAGE_B(PG8_SB(1, 1), cB + hstep + kstep);
    PG8_WAIT_V(6); PG8_BAR;
    for (;;) {
        const bool has_next = S.next(ui + 1, nxt);
        const unsigned nB = has_next ? (unsigned)nxt.pn * tstep : cB;
#pragma unroll 1
        for (int t = 0; t < nt; t += 2) {
            const bool last = (t == nt - 2);
            const unsigned k1 = (unsigned)(t + 1) * kstep;
            const unsigned k2 = last ? 0u : (unsigned)(t + 2) * kstep, k3 = k2 + kstep;
            const unsigned b2 = last ? nB : cB + (unsigned)(t + 2) * kstep, b3 = b2 + kstep;
            if (last) E.prefetch(cur, wr, wc, lane, epi);
            PG8_LDB(B0, 0, 0); PG8_LDB(B1, 0, 1); PG8_SCHED; PG8_LDA(At, 0, 0); PG8_STAGE_A(PG8_SA(1, 1), k1, 1);
            if (last && has_next) {
#pragma unroll
                for (int h = 0; h < 2; ++h)
#pragma unroll
                    for (int i = 0; i < 2; ++i) coff[h][i] = S.a_off(ui + 1, nxt, HALF * h + Ra[i]) + Ca2[i];
            }
            PG8_WAIT_V(8); PG8_WAIT_L(0); PG8_BAR; PG8_MMA(0, 0, At, B0); PG8_MMA(0, 1, At, B1); PG8_BAR; PG8_SCHED;
            PG8_LDA(At, 0, 1); PG8_STAGE_B(PG8_SB(0, 0), b2); PG8_STAGE_B(PG8_SB(0, 1), b2 + hstep); PG8_STAGE_A(PG8_SA(0, 0), k2, 0);
            PG8_WAIT_V(8); PG8_WAIT_L(0); PG8_BAR; PG8_MMA(1, 0, At, B0); PG8_MMA(1, 1, At, B1); PG8_BAR; PG8_SCHED;
            PG8_LDB(B0, 1, 0); PG8_LDB(B1, 1, 1); PG8_SCHED; PG8_LDA(At, 1, 0); PG8_STAGE_A(PG8_SA(0, 1), k2, 1);
            PG8_WAIT_V(8); PG8_WAIT_L(0); PG8_BAR; PG8_MMA(0, 0, At, B0); PG8_MMA(0, 1, At, B1); PG8_BAR; PG8_SCHED;
            PG8_LDA(At, 1, 1); PG8_STAGE_B(PG8_SB(1, 0), b3); PG8_STAGE_B(PG8_SB(1, 1), b3 + hstep); PG8_STAGE_A(PG8_SA(1, 0), k3, 0);
            PG8_WAIT_V(8); PG8_WAIT_L(0); PG8_BAR; PG8_MMA(1, 0, At, B0); PG8_MMA(1, 1, At, B1); PG8_BAR; PG8_SCHED;
        }
        if constexpr (ALIGN_EPI) { if (wr == 0) PG8_BAR; }
        E(acc, cur, wr, wc, fr, fq, (const LAS float*)epi);
        if (!has_next) break;
#pragma unroll
        for (int a = 0; a < 2; ++a)
#pragma unroll
            for (int b = 0; b < 2; ++b)
#pragma unroll
                for (int m = 0; m < 4; ++m)
#pragma unroll
                    for (int n = 0; n < 2; ++n) acc[a][b][m][n] = (f32x4){0.f, 0.f, 0.f, 0.f};
        cur = nxt; cB = nB; ++ui;
        if constexpr (ALIGN_EPI) { if (wr == 1) PG8_BAR; }
    }
    PG8_WAIT_V(0);
    if constexpr (!ALIGN_EPI) { if (wr == 0) PG8_BAR; }
    PG8_BAR;
#undef PG8_SA
#undef PG8_SB
#undef PG8_STAGE_A
#undef PG8_STAGE_B
#undef PG8_LD32
#undef PG8_LDA
#undef PG8_LDB
#undef PG8_MMA
#undef PG8_WAIT_V
#undef PG8_WAIT_L
#undef PG8_BAR
#undef PG8_SCHED
}

struct StaticOrder {
    int nM, nN, nwg, G, c, K;
    __device__ __forceinline__ void init(int M, int N, int K_, int G_, int c_) { nM = M / 256; nN = N / 256; nwg = nM * nN; G = G_; c = c_; K = K_; }
    __device__ __forceinline__ bool next(int i, Unit& u) const {
        const long L = (long)i * G + c; if (L >= nwg) return false;
        int wgid = (int)L; { const int q = nwg / 8, r = nwg % 8, xcd = wgid % 8, off = wgid / 8; wgid = (xcd < r ? xcd * (q + 1) : r * (q + 1) + (xcd - r) * q) + off; }
        const int nig = 8 * nN, gid = wgid / nig, fm = gid * 8, gsz = (nM - fm) < 8 ? (nM - fm) : 8;
        u.pm = fm + ((wgid % nig) % gsz); u.pn = (wgid % nig) / gsz; return true;
    }
    __device__ __forceinline__ unsigned a_off(int, const Unit& u, int r) const { return (unsigned)((u.pm * 256 + r) * K) * 2u; }
};
template <bool GATHER> struct MoeOrder {
    int NPN, start, end, per, slot, K  ; const LAS int* tile_e; const LAS unsigned short* tokl;
    __device__ __forceinline__ void init(int MT, int NPN_, int K_, int G, int c, const LAS int* tile_e_, const LAS unsigned short* tokl_) {
        NPN = NPN_; K = K_; tile_e = tile_e_; tokl = tokl_;
        const int U = MT * NPN, nx = (G % 8 == 0) ? 8 : 1; per = G / nx; const int x = c % nx; slot = c / nx;
        const int q = U / nx, r = U % nx; start = (x < r) ? x * (q + 1) : r * (q + 1) + (x - r) * q; end = start + ((x < r) ? q + 1 : q);
    }
    __device__ __forceinline__ bool next(int i, Unit& u) const { const int L = start + i * per + slot; if (L >= end) return false; const int mt = L / NPN, pn = L - mt * NPN; u.pm = mt; u.pn = tile_e[mt] * NPN + pn; return true; }
    __device__ __forceinline__ unsigned a_off(int ui, const Unit& u, int r) const { const unsigned row = GATHER ? (unsigned)tokl[ui * 256 + r] : (unsigned)(u.pm * 256 + r); return row * (unsigned)K; }
};

struct EpiInProj {
    bf16 *Q, *Kb, *V, *GB, *CU; const float* qw; const float* kw;
    __device__ __forceinline__ void prefetch(const Unit& u, int wr, int wc, int lane, LAS float* scr) const {
        __builtin_amdgcn_global_load_lds((const unsigned*)(((u.pn < 2) ? qw : kw) + lane), (LAS unsigned*)scr, 4, 0, 0); }
    __device__ __forceinline__ void operator()(const f32x4 (&acc)[2][2][4][2], const Unit& u, int wr, int wc, int fr, int fq, const LAS float* scr) const {
        const int row0 = u.pm * 256 + wr * 64 + fr, pn = u.pn;
        if (pn < 4) {
            const float sc = (pn < 2) ? C2 : 1.f; bf16* O = (pn < 2) ? Q : Kb;
            float w[2][2][4];
#pragma unroll
            for (int bj = 0; bj < 2; ++bj)
#pragma unroll
                for (int n = 0; n < 2; ++n) { const f32x4 t4 = *(const LAS f32x4*)(scr + 32 * bj + 8 * fq + 4 * n);
#pragma unroll
                    for (int i = 0; i < 4; ++i) w[bj][n][i] = t4[i] * sc; }
#pragma unroll
            for (int ai = 0; ai < 2; ++ai)
#pragma unroll
                for (int m = 0; m < 4; ++m) {
                    float ss = 0.f;
#pragma unroll
                    for (int bj = 0; bj < 2; ++bj)
#pragma unroll
                        for (int n = 0; n < 2; ++n) { const f32x4 v = acc[ai][bj][m][n]; ss += (v[0] * v[0] + v[1] * v[1]) + (v[2] * v[2] + v[3] * v[3]); }
                    ss += __shfl_xor(ss, 16); ss += __shfl_xor(ss, 32);
                    const float rstd = rsqrtf(ss * (1.f / 64.f) + EPS);
                    bf16* rowp = O + (size_t)(row0 + ai * 128 + m * 16) * DA + 256 * (pn & 1) + 64 * wc + 8 * fq;
#pragma unroll
                    for (int bj = 0; bj < 2; ++bj) { const f32x4 v0 = acc[ai][bj][m][0], v1 = acc[ai][bj][m][1]; u32x4 o;
                        o.x = cvtpk(v0[0] * rstd * w[bj][0][0], v0[1] * rstd * w[bj][0][1]); o.y = cvtpk(v0[2] * rstd * w[bj][0][2], v0[3] * rstd * w[bj][0][3]);
                        o.z = cvtpk(v1[0] * rstd * w[bj][1][0], v1[1] * rstd * w[bj][1][1]); o.w = cvtpk(v1[2] * rstd * w[bj][1][2], v1[3] * rstd * w[bj][1][3]);
                        *(u32x4*)(rowp + 32 * bj) = o; }
                }
        } else if (pn < 8) {
            bf16* O = (pn < 6) ? V : GB; const int ct = 256 * (pn & 1);
#pragma unroll
            for (int ai = 0; ai < 2; ++ai)
#pragma unroll
                for (int m = 0; m < 4; ++m) { bf16* rowp = O + (size_t)(row0 + ai * 128 + m * 16) * DA + ct + 32 * wc + 8 * fq;
#pragma unroll
                    for (int bj = 0; bj < 2; ++bj) { const f32x4 v0 = acc[ai][bj][m][0], v1 = acc[ai][bj][m][1]; u32x4 o;
                        o.x = cvtpk(v0[0], v0[1]); o.y = cvtpk(v0[2], v0[3]); o.z = cvtpk(v1[0], v1[1]); o.w = cvtpk(v1[2], v1[3]);
                        *(u32x4*)(rowp + 128 * bj) = o; } }
        } else {
            const int ct = 128 * (pn - 8);
#pragma unroll
            for (int ai = 0; ai < 2; ++ai)
#pragma unroll
                for (int m = 0; m < 4; ++m) { bf16* rowp = CU + (size_t)(row0 + ai * 128 + m * 16) * DC + ct + 32 * wc + 8 * fq;
                    const f32x4 v0 = acc[ai][0][m][0] * acc[ai][1][m][0], v1 = acc[ai][0][m][1] * acc[ai][1][m][1]; u32x4 o;
                    o.x = cvtpk(v0[0], v0[1]); o.y = cvtpk(v0[2], v0[3]); o.z = cvtpk(v1[0], v1[1]); o.w = cvtpk(v1[2], v1[3]);
                    *(u32x4*)rowp = o; }
        }
    }
};
struct EpiOutProj {
    bf16* D; const float* modf;
    __device__ __forceinline__ void prefetch(const Unit& u, int wr, int wc, int lane, LAS float* scr) const {
        const int b = (u.pm * 256) / SEQ, c0 = u.pn * 256 + 32 * wc;
        __builtin_amdgcn_global_load_lds((const unsigned*)(modf + (size_t)b * NMOD + 2 * DM + ((lane < 32) ? c0 + lane : c0 + 128 + lane - 32)), (LAS unsigned*)scr, 4, 0, 0); }
    __device__ __forceinline__ void operator()(const f32x4 (&acc)[2][2][4][2], const Unit& u, int wr, int wc, int fr, int fq, const LAS float* scr) const {
        const int row0 = u.pm * 256 + wr * 64 + fr, col0 = u.pn * 256 + 32 * wc + 8 * fq;
        f32x4 g[2][2];
#pragma unroll
        for (int bj = 0; bj < 2; ++bj)
#pragma unroll
            for (int n = 0; n < 2; ++n) g[bj][n] = *(const LAS f32x4*)(scr + 32 * bj + 8 * fq + 4 * n);
#pragma unroll
        for (int ai = 0; ai < 2; ++ai)
#pragma unroll
            for (int m = 0; m < 4; ++m) { bf16* rowp = D + (size_t)(row0 + ai * 128 + m * 16) * DM + col0;
#pragma unroll
                for (int bj = 0; bj < 2; ++bj) { const f32x4 v0 = g[bj][0] * acc[ai][bj][m][0], v1 = g[bj][1] * acc[ai][bj][m][1]; u32x4 o;
                    o.x = cvtpk(v0[0], v0[1]); o.y = cvtpk(v0[2], v0[3]); o.z = cvtpk(v1[0], v1[1]); o.w = cvtpk(v1[2], v1[3]);
                    store16_wt(rowp + 128 * bj, o); } }
    }
};
struct EpiGate {
    unsigned char* ACT; const float* bgu_all;
    __device__ __forceinline__ void prefetch(const Unit& u, int wr, int wc, int lane, LAS float* sc) const {
        const int e = u.pn >> 3, c0 = 128 * (u.pn & 7) + 32 * wc; const float* bgu = bgu_all + (size_t)e * 2 * DE;
        __builtin_amdgcn_global_load_lds((const unsigned*)(bgu + ((lane < 32) ? c0 + lane : DE + c0 + lane - 32)), (LAS unsigned*)sc, 4, 0, 0); }
    __device__ __forceinline__ void operator()(const f32x4 (&acc)[2][2][4][2], const Unit& u, int wr, int wc, int fr, int fq, const LAS float* sc) const {
        const int ch0 = 128 * (u.pn & 7) + 32 * wc + 8 * fq, slot0 = u.pm * 256;
        f32x4 bg[2], bu[2];
#pragma unroll
        for (int n = 0; n < 2; ++n) { bg[n] = *(const LAS f32x4*)(sc + 8 * fq + 4 * n); bu[n] = *(const LAS f32x4*)(sc + 32 + 8 * fq + 4 * n); }
#pragma unroll
        for (int ai = 0; ai < 2; ++ai)
#pragma unroll
            for (int m = 0; m < 4; ++m) { const int rl = ai * 128 + wr * 64 + m * 16 + fr; float a[8];
#pragma unroll
                for (int n = 0; n < 2; ++n)
#pragma unroll
                    for (int i = 0; i < 4; ++i) { float gt = acc[ai][0][m][n][i] * (1.f / WSCALE) + bg[n][i], up = acc[ai][1][m][n][i] * (1.f / WSCALE) + bu[n][i];
                        gt = fminf(gt, 7.f); up = fminf(fmaxf(up, -7.f), 7.f);
                        a[4 * n + i] = gt * __builtin_amdgcn_rcpf(1.f + __builtin_amdgcn_exp2f(-1.702f * LOG2E * gt)) * (up + 1.f); }
                u32x2 o; o.x = pack4_fp8(a[0], a[1], a[2], a[3]); o.y = pack4_fp8(a[4], a[5], a[6], a[7]);
                *(u32x2*)(ACT + (size_t)(slot0 + rl) * DE + ch0) = o; }
    }
};
struct EpiDown {
    unsigned char* Y; const float* bd_all; const float* roww_all; const LAS int* ecnt; const LAS int* etile0;
    __device__ __forceinline__ void prefetch(const Unit& u, int wr, int wc, int lane, LAS float* sc) const {
        const int e = u.pn >> 2, c0 = 256 * (u.pn & 3) + 32 * wc, lt = u.pm - etile0[e];
        const float* bd = bd_all + (size_t)e * DM; const float* roww = roww_all + (size_t)e * ECAP + lt * 256 + wr * 64 + lane;
        __builtin_amdgcn_global_load_lds((const unsigned*)(bd + ((lane < 32) ? c0 + lane : c0 + 128 + lane - 32)), (LAS unsigned*)sc, 4, 0, 0);
        __builtin_amdgcn_global_load_lds((const unsigned*)roww, (LAS unsigned*)(sc + 64), 4, 0, 0);
        __builtin_amdgcn_global_load_lds((const unsigned*)(roww + 128), (LAS unsigned*)(sc + 128), 4, 0, 0); }
    __device__ __forceinline__ void operator()(const f32x4 (&acc)[2][2][4][2], const Unit& u, int wr, int wc, int fr, int fq, const LAS float* sc) const {
        const int col0 = 256 * (u.pn & 3) + 32 * wc + 8 * fq, slot0 = u.pm * 256;
        f32x4 bv[2][2];
#pragma unroll
        for (int bj = 0; bj < 2; ++bj)
#pragma unroll
            for (int n = 0; n < 2; ++n) bv[bj][n] = *(const LAS f32x4*)(sc + 32 * bj + 8 * fq + 4 * n);
        const bool odd = (fq & 1) != 0; const int cb = col0 - 8 * (fq & 1);
#pragma unroll
        for (int ai = 0; ai < 2; ++ai)
#pragma unroll
            for (int mp = 0; mp < 2; ++mp) {
                u32x2 pk[2][2];
#pragma unroll
                for (int j = 0; j < 2; ++j) { const int m = 2 * mp + j; const float w = sc[64 + 64 * ai + 16 * m + fr] * YSCALE;
#pragma unroll
                    for (int bj = 0; bj < 2; ++bj) { const f32x4 v0 = (acc[ai][bj][m][0] * (1.f / WSCALE) + bv[bj][0]) * w, v1 = (acc[ai][bj][m][1] * (1.f / WSCALE) + bv[bj][1]) * w;
                        pk[j][bj].x = pack4_fp8(v0[0], v0[1], v0[2], v0[3]); pk[j][bj].y = pack4_fp8(v1[0], v1[1], v1[2], v1[3]); } }
                const int rl = ai * 128 + wr * 64 + (2 * mp + (odd ? 1 : 0)) * 16 + fr;
#pragma unroll
                for (int bj = 0; bj < 2; ++bj) { const u32x2 mine = odd ? pk[1][bj] : pk[0][bj], send = odd ? pk[0][bj] : pk[1][bj]; u32x2 got;
                    got.x = (unsigned)__shfl_xor((int)send.x, 16); got.y = (unsigned)__shfl_xor((int)send.y, 16);
                    u32x4 o; if (odd) { o.x = got.x; o.y = got.y; o.z = mine.x; o.w = mine.y; } else { o.x = mine.x; o.y = mine.y; o.z = got.x; o.w = got.y; }
                    *(u32x4*)(Y + (size_t)(slot0 + rl) * DM + cb + 128 * bj) = o; } }
    }
};


namespace attn_body {
using bf16x8=__attribute__((ext_vector_type(8)))short;
using s16x4=__attribute__((ext_vector_type(4)))short;
using f32x16=__attribute__((ext_vector_type(16)))float;
using u32x4=__attribute__((ext_vector_type(4)))unsigned;
typedef unsigned short bf16;
constexpr int BATCH=NB,NHEAD=NH,D=64,ADM=NHEAD*D;
constexpr int NW=8,QBLK=32,QB=QBLK*NW,KVBLK=64,NQB=SEQ/QB;
__device__ __forceinline__ int crow(int r,int hi){return (r&3)+8*(r>>2)+4*hi;}
#define SBAR() __builtin_amdgcn_sched_barrier(0)
__device__ __forceinline__ void cmask(f32x16&p0,f32x16&p1,int jb,int qrel,int hi){
  const float NEG=-INFINITY; int kb=64*jb+4*hi;
  #pragma unroll
  for(int r=0;r<16;++r){int kv=kb+(r&3)+8*(r>>2); if(kv>qrel)p0[r]=NEG; if(kv+32>qrel)p1[r]=NEG;}
}
constexpr int NSLOT=3, SLOTB=8192;
constexpr int LDS_K=0, LDS_V=NSLOT*SLOTB, LDS_WS=2*NSLOT*SLOTB, LDS_OST=LDS_WS+NW*64*4, LDS_FL=LDS_OST+NW*4096, LDS_BYTES_A=LDS_FL+SEQ*4;
__device__ __forceinline__ void glds16(const void*gsrc,unsigned lds_dst){unsigned keep;
  asm volatile("s_mov_b32 %0, m0\n\ts_mov_b32 m0, %2\n\ts_nop 0\n\tglobal_load_lds_dwordx4 %1, off\n\ts_mov_b32 m0, %0":"=&s"(keep):"v"(gsrc),"s"(lds_dst):"memory");}
__device__ __forceinline__ float max3f(float a,float b,float c){float r;asm("v_max3_f32 %0, %1, %2, %3":"=v"(r):"v"(a),"v"(b),"v"(c));return r;}
__device__ __forceinline__ float max2f(float a,float b){float r;asm("v_max_f32_e32 %0, %1, %2":"=v"(r):"v"(a),"v"(b));return r;}
__device__ __forceinline__ float fadd_s(float a,float b){float r;asm("v_add_f32_e32 %0, %1, %2":"=v"(r):"v"(a),"v"(b));return r;}
__device__ __forceinline__ float fsub_s(float a,float b){float r;asm("v_sub_f32_e32 %0, %1, %2":"=v"(r):"v"(a),"v"(b));return r;}
__device__ __forceinline__ unsigned cvtpk_s(float lo,float hi){f32x2 v={lo,hi};bf16x2_t b=__builtin_convertvector(v,bf16x2_t);return __builtin_bit_cast(unsigned,b);}
#define WAIT_BAR(N) asm volatile("s_waitcnt vmcnt(" #N ") lgkmcnt(0)\n\ts_barrier":::"memory")
typedef __attribute__((address_space(3))) const char* lds_cptr;
typedef short v4i16_t __attribute__((ext_vector_type(4)));
__device__ __forceinline__ void qkt(f32x16&p0,f32x16&p1,const char*Kslot,const bf16x8*qr,int r32,int hi){
  const char*kb=Kslot+hi*1024+r32*16;
  #pragma unroll
  for(int d0=0;d0<4;++d0){
    const bf16x8 b0=*reinterpret_cast<const bf16x8*>(kb+d0*2048);
    const bf16x8 b1=*reinterpret_cast<const bf16x8*>(kb+d0*2048+512);
    p0=__builtin_amdgcn_mfma_f32_32x32x16_bf16(b0,qr[d0],p0,0,0,0);p1=__builtin_amdgcn_mfma_f32_32x32x16_bf16(b1,qr[d0],p1,0,0,0);}
}
__device__ __forceinline__ void kload8(bf16x8*kf,lds_cptr kp){
  kf[0]=*(const __attribute__((address_space(3))) bf16x8*)(kp);      kf[1]=*(const __attribute__((address_space(3))) bf16x8*)(kp+512);
  kf[2]=*(const __attribute__((address_space(3))) bf16x8*)(kp+2048); kf[3]=*(const __attribute__((address_space(3))) bf16x8*)(kp+2560);
  kf[4]=*(const __attribute__((address_space(3))) bf16x8*)(kp+4096); kf[5]=*(const __attribute__((address_space(3))) bf16x8*)(kp+4608);
  kf[6]=*(const __attribute__((address_space(3))) bf16x8*)(kp+6144); kf[7]=*(const __attribute__((address_space(3))) bf16x8*)(kp+6656);
}
__device__ __forceinline__ void kload2(bf16x8*kf,lds_cptr kp,int j){ kf[2*j]=*(const __attribute__((address_space(3))) bf16x8*)(kp+j*2048); kf[2*j+1]=*(const __attribute__((address_space(3))) bf16x8*)(kp+j*2048+512); }
__device__ __forceinline__ s16x4 vtr(lds_cptr p){ return __builtin_bit_cast(s16x4,__builtin_amdgcn_ds_read_tr16_b64_v4i16((__attribute__((address_space(3))) v4i16_t*)p)); }
__device__ __forceinline__ float rowmax(const f32x16&p0,const f32x16&p1){
  float a=max3f(p0[0],p0[1],p1[0]),b=max3f(p0[2],p0[3],p1[1]);a=max3f(a,p1[2],p1[3]);
  #pragma unroll
  for(int r=4;r<16;r+=4){a=max3f(a,p0[r],p0[r+1]);b=max3f(b,p0[r+2],p0[r+3]);a=max3f(a,p1[r],p1[r+1]);b=max3f(b,p1[r+2],p1[r+3]);}
  const float m=max2f(a,b);
  auto rr=__builtin_amdgcn_permlane32_swap(__float_as_uint(m),__float_as_uint(m),false,false);
  return max2f(__uint_as_float(rr[0]),__uint_as_float(rr[1]));
}
__device__ __forceinline__ void pv(f32x16*o,int vb,bf16x8 pa0,bf16x8 pa1,bf16x8 pa2,bf16x8 pa3){
  #pragma unroll
  for(int d0=0;d0<2;++d0){s16x4 lo[4],hi[4];
    #pragma unroll
    for(int ks=0;ks<4;++ks){
      asm volatile("ds_read_b64_tr_b16 %0,%1 offset:%c2":"=&v"(lo[ks]):"v"(vb),"i"(d0*4096+ks*1024):"memory");
      asm volatile("ds_read_b64_tr_b16 %0,%1 offset:%c2":"=&v"(hi[ks]):"v"(vb),"i"(d0*4096+ks*1024+512):"memory");}
    asm volatile("s_waitcnt lgkmcnt(0)":::"memory");SBAR();
    #define PK(k) (bf16x8){lo[k][0],lo[k][1],lo[k][2],lo[k][3],hi[k][0],hi[k][1],hi[k][2],hi[k][3]}
    o[d0]=__builtin_amdgcn_mfma_f32_32x32x16_bf16(pa0,PK(0),o[d0],0,0,0);
    o[d0]=__builtin_amdgcn_mfma_f32_32x32x16_bf16(pa1,PK(1),o[d0],0,0,0);
    o[d0]=__builtin_amdgcn_mfma_f32_32x32x16_bf16(pa2,PK(2),o[d0],0,0,0);
    o[d0]=__builtin_amdgcn_mfma_f32_32x32x16_bf16(pa3,PK(3),o[d0],0,0,0);
    #undef PK
  }
}
typedef __attribute__((address_space(3))) const float* lds_fptr;
#define FLD(key0,g,half) (*(const __attribute__((address_space(3))) f32x4*)(flp+(key0)+32*(half)+8*(g)))
template<int THRL> __device__ __forceinline__ void attn_unit(int b,int h,int qb,const bf16*Q,const bf16*__restrict__ K,const bf16*__restrict__ V,bf16*O,char*shm){
  const int tid=opaque_tid(),lane=tid&63,r32=lane&31,hi=lane>>5; const int wid=__builtin_amdgcn_readfirstlane(tid>>6);
  const long rowbase=(long)b*SEQ; const int q0=qb*QB;
  const bf16*Qw=Q+(rowbase+q0+wid*QBLK)*ADM+h*D;
  const bf16*Kh=K+rowbase*ADM+h*D,*Vh=V+rowbase*ADM+h*D;
  const unsigned lds0=(unsigned)(uintptr_t)shm;
  float*wsf=(float*)(shm+LDS_WS)+wid*64;
  const bf16*ksrc=Kh+(long)lane*ADM+wid*8;
  const bf16*vsrc=Vh+(long)(16*(wid&3)+(lane>>2))*ADM+(wid>>2)*32+(lane&3)*8;
  const unsigned kdst=lds0+LDS_K+wid*1024, vdst=lds0+LDS_V+wid*1024;
  #define DMA_K(t,slot) glds16(ksrc+(long)(t)*KVBLK*ADM,(unsigned)__builtin_amdgcn_readfirstlane(kdst+(slot)))
  #define DMA_V(t,slot) glds16(vsrc+(long)(t)*KVBLK*ADM,(unsigned)__builtin_amdgcn_readfirstlane(vdst+(slot)))
  const int vb0=(int)(lds0+LDS_V)+((lane>>4)&1)*32+(lane&3)*8+(4*hi+((lane&15)>>2))*64;
  const char*Kbase=shm+LDS_K; bf16x8 kf[8];
  const lds_cptr shm3=(lds_cptr)shm; const lds_cptr kp0=shm3+LDS_K+hi*1024+r32*16; const lds_cptr vp0=shm3+LDS_V+((lane>>4)&1)*32+(lane&3)*8+(4*hi+((lane&15)>>2))*64;
  const lds_fptr flp=(lds_fptr)(shm3+LDS_FL)+4*hi;
  const int NT=(q0+QB)/KVBLK;
  DMA_K(0,0);DMA_V(0,0);DMA_K(1,SLOTB);
  bf16x8 qr[4];
  #pragma unroll
  for(int d0=0;d0<4;++d0)qr[d0]=*reinterpret_cast<const bf16x8*>(&Qw[(long)r32*ADM+d0*16+hi*8]);
  float mhat=0.f,l_reg=0.f;f32x16 o[2];o[0]=f32x16{};o[1]=f32x16{};
  const int qrel=wid*QBLK+r32;
  float nm=((lds_fptr)(shm3+LDS_FL))[q0+qrel];
  #define CMASK(P0,P1,t) do{int jb_=(t)-(NT-4); if(jb_>=0)cmask(P0,P1,jb_,qrel,hi);}while(0)
  bool resc=false;
  #define START(P0,P1) do{ const float rm=rowmax(P0,P1); resc=false; \
    { const float dl=rm; mhat=fadd_s(mhat,dl); nm=fsub_s(nm,dl); \
      _Pragma("unroll") for(int r=0;r<16;++r){P0[r]=fsub_s(P0[r],dl);P1[r]=fsub_s(P1[r],dl);} } \
    _Pragma("unroll") for(int r=0;r<16;++r)P0[r]=__builtin_amdgcn_exp2f(P0[r]); }while(0)
  #define RESC() do{ if(resc){ asm volatile("s_waitcnt lgkmcnt(0)":::"memory"); \
      _Pragma("unroll") for(int d_=0;d_<2;++d_) _Pragma("unroll") for(int r=0;r<16;++r)o[d_][r]*=wsf[crow(r,hi)]; } }while(0)
  f32x16 pA0,pA1,pB0,pB1;
  int sl_prev=0,sl_cur=0,sl_next=SLOTB;
  #define ROT() do{sl_prev=sl_cur;sl_cur=sl_next;sl_next=(sl_next==(NSLOT-1)*SLOTB)?0:sl_next+SLOTB;}while(0)
  DMA_K(2,2*SLOTB);
  #pragma unroll
  for(int g=0;g<4;++g){ const f32x4 f0=FLD(0,g,0), f1=FLD(0,g,1);
    #pragma unroll
    for(int j=0;j<4;++j){ pA0[4*g+j]=nm-f0[j]; pA1[4*g+j]=nm-f1[j]; } }
  WAIT_BAR(3);
  qkt(pA0,pA1,Kbase,qr,r32,hi);asm volatile("s_nop 15\n\ts_nop 7":"+v"(pA0),"+v"(pA1));CMASK(pA0,pA1,0);
  START(pA0,pA1);
  _Pragma("unroll") for(int r=0;r<16;++r)pA1[r]=__builtin_amdgcn_exp2f(pA1[r]);
  #pragma unroll
  for(int g=0;g<4;++g){ const f32x4 f0=FLD(64,g,0), f1=FLD(64,g,1);
    #pragma unroll
    for(int j=0;j<4;++j){ pB0[4*g+j]=nm-f0[j]; pB1[4*g+j]=nm-f1[j]; } }
  WAIT_BAR(0);
  DMA_K(3,0);DMA_V(1,SLOTB);
  ROT();
  kload8(kf,kp0+sl_cur);
  WAIT_BAR(2);
  s16x4 vlo[8],vhi[8]; u32x4 pw0,pw1,pw2,pw3;
  #define PKW(P,B) cvtpk_s(P[B],P[B+1])
  #define PAF(k) __builtin_bit_cast(bf16x8,pw##k)
  #define VFR(i) (bf16x8){vlo[i][0],vlo[i][1],vlo[i][2],vlo[i][3],vhi[i][0],vhi[i][1],vhi[i][2],vhi[i][3]}
  #define PIN(x) asm volatile("":"+v"(x))
  #define MX3(a,b,c) __builtin_fmaxf(__builtin_fmaxf((a),(b)),(c))
  #define GAPA(MF,A0,A1,A2,A3,W0,W1,PW) do{ MF; sacc+=A0; sacc+=A1; sacc+=A2; sacc+=A3; PIN(sacc); W0; W1; PIN(PW); SBAR(); }while(0)
  #define EX(v) __builtin_amdgcn_exp2f(v)
    \
  #define GAPB(MF,X,B,GF,NX,G,HALF,key0n) do{ MF; X[B]=EX(X[B]); X[B+1]=EX(X[B+1]); X[B+2]=EX(X[B+2]); X[B+3]=EX(X[B+3]); PIN(X); \
      if(GF){ const f32x4 f_=FLD(key0n,G,HALF); NX[4*(G)]=nm-f_[0]; NX[4*(G)+1]=nm-f_[1]; NX[4*(G)+2]=nm-f_[2]; NX[4*(G)+3]=nm-f_[3]; PIN(NX); } SBAR(); }while(0)
  #define VRD(i) do{ vlo[i]=vtr(vp_+(((i)>>2)*4096+((i)&3)*1024)); vhi[i]=vtr(vp_+(((i)>>2)*4096+((i)&3)*1024+512)); }while(0)
  #define KRD(G,j) do{ if(G){ kload2(kf,kp0+sl_next,j); SBAR(); } }while(0)
  #define STEP(C0,C1,P0,P1,t,GK,GV,GL) do{ SBAR(); \
    const lds_cptr vp_=vp0+sl_prev; const int kn_=64*((t)+1); \
    VRD(0); SBAR(); float sacc=(P0[0]+P0[1]); \
    GAPA(C0=__builtin_amdgcn_mfma_f32_32x32x16_bf16(kf[0],qr[0],C0,0,0,0), P0[2],P0[3],P0[4],P0[5],     pw0[0]=PKW(P0,0), pw0[1]=PKW(P0,2), pw0); \
    VRD(4); SBAR(); GAPA(C1=__builtin_amdgcn_mfma_f32_32x32x16_bf16(kf[1],qr[0],C1,0,0,0), P0[6],P0[7],P0[8],P0[9],     pw0[2]=PKW(P0,4), pw0[3]=PKW(P0,6), pw0); \
    VRD(1); SBAR(); GAPA(C0=__builtin_amdgcn_mfma_f32_32x32x16_bf16(kf[2],qr[1],C0,0,0,0),   P0[10],P0[11],P0[12],P0[13], pw1[0]=PKW(P0,8), pw1[1]=PKW(P0,10), pw1); \
    VRD(5); SBAR(); GAPA(C1=__builtin_amdgcn_mfma_f32_32x32x16_bf16(kf[3],qr[1],C1,0,0,0),   P0[14],P0[15],P1[0],P1[1],   pw1[2]=PKW(P0,12),pw1[3]=PKW(P0,14), pw1); \
    VRD(2); SBAR(); GAPA(C0=__builtin_amdgcn_mfma_f32_32x32x16_bf16(kf[4],qr[2],C0,0,0,0),   P1[2],P1[3],P1[4],P1[5],     pw2[0]=PKW(P1,0), pw2[1]=PKW(P1,2), pw2); \
    VRD(6); SBAR(); GAPA(C1=__builtin_amdgcn_mfma_f32_32x32x16_bf16(kf[5],qr[2],C1,0,0,0),   P1[6],P1[7],P1[8],P1[9],     pw2[2]=PKW(P1,4), pw2[3]=PKW(P1,6), pw2); \
    VRD(3); SBAR(); GAPA(C0=__builtin_amdgcn_mfma_f32_32x32x16_bf16(kf[6],qr[3],C0,0,0,0),   P1[10],P1[11],P1[12],P1[13], pw3[0]=PKW(P1,8), pw3[1]=PKW(P1,10), pw3); \
    VRD(7); SBAR(); GAPA(C1=__builtin_amdgcn_mfma_f32_32x32x16_bf16(kf[7],qr[3],C1,0,0,0),   P1[14],P1[15],0.f,0.f,       pw3[2]=PKW(P1,12),pw3[3]=PKW(P1,14), pw3); \
    l_reg+=sacc; \
    if(GK){DMA_K((t)+3,sl_cur);} if(GV){DMA_V((t)+1,sl_next);} \
    CMASK(C0,C1,t); \
    { float a=MX3(C0[0],C0[1],C1[0]),b=MX3(C0[2],C0[3],C1[1]); a=MX3(a,C1[2],C1[3]); \
      _Pragma("unroll") for(int r=4;r<16;r+=4){a=MX3(a,C0[r],C0[r+1]);b=MX3(b,C0[r+2],C0[r+3]);a=MX3(a,C1[r],C1[r+1]);b=MX3(b,C1[r+2],C1[r+3]);} \
      float rm=__builtin_fmaxf(a,b); { auto rr=__builtin_amdgcn_permlane32_swap(__float_as_uint(rm),__float_as_uint(rm),false,false); rm=__builtin_fmaxf(__uint_as_float(rr[0]),__uint_as_float(rr[1])); } \
      resc=false; \
      if(__builtin_expect(__any(rm>(float)THRL),0)){ const float dl=__builtin_fmaxf(rm,0.f); mhat+=dl; nm-=dl; \
        _Pragma("unroll") for(int r=0;r<16;++r){C0[r]-=dl;C1[r]-=dl;} \
        const float f=__builtin_amdgcn_exp2f(-dl); l_reg*=f; if(hi==0)wsf[r32]=f; resc=true; } } \
    SBAR(); \
    GAPB(o[0]=__builtin_amdgcn_mfma_f32_32x32x16_bf16(PAF(0),VFR(0),o[0],0,0,0), C0,0,  true,P0,0,0,kn_); \
    GAPB(o[1]=__builtin_amdgcn_mfma_f32_32x32x16_bf16(PAF(0),VFR(4),o[1],0,0,0), C0,4,  true,P0,1,0,kn_); \
    KRD(GL,0); GAPB(o[0]=__builtin_amdgcn_mfma_f32_32x32x16_bf16(PAF(1),VFR(1),o[0],0,0,0), C0,8,  true,P0,2,0,kn_); \
    KRD(GL,1); GAPB(o[1]=__builtin_amdgcn_mfma_f32_32x32x16_bf16(PAF(1),VFR(5),o[1],0,0,0), C0,12, true,P0,3,0,kn_); \
    KRD(GL,2); GAPB(o[0]=__builtin_amdgcn_mfma_f32_32x32x16_bf16(PAF(2),VFR(2),o[0],0,0,0), C1,0,  true,P1,0,1,kn_); \
    KRD(GL,3); GAPB(o[1]=__builtin_amdgcn_mfma_f32_32x32x16_bf16(PAF(2),VFR(6),o[1],0,0,0), C1,4,  true,P1,1,1,kn_); \
    GAPB(o[0]=__builtin_amdgcn_mfma_f32_32x32x16_bf16(PAF(3),VFR(3),o[0],0,0,0), C1,8,  true,P1,2,1,kn_); \
    GAPB(o[1]=__builtin_amdgcn_mfma_f32_32x32x16_bf16(PAF(3),VFR(7),o[1],0,0,0), C1,12, true,P1,3,1,kn_); \
    }while(0)
  int t=1;
  #undef CMASK
  #define CMASK(P0,P1,t) do{}while(0)
  for(;t+5<NT;t+=2){
    STEP(pB0,pB1,pA0,pA1,t,true,true,true);     WAIT_BAR(2); RESC(); ROT();
    STEP(pA0,pA1,pB0,pB1,t+1,true,true,true);   WAIT_BAR(2); RESC(); ROT();
  }
  #undef CMASK
  #define CMASK(P0,P1,t) do{int jb_=(t)-(NT-4); if(jb_>=0)cmask(P0,P1,jb_,qrel,hi);}while(0)
  #define ENDW(tt) do{ if((tt)+3<NT){WAIT_BAR(2);} else if((tt)+2<NT){WAIT_BAR(1);} else {WAIT_BAR(0);} }while(0)
  for(;t+1<NT;t+=2){
    STEP(pB0,pB1,pA0,pA1,t,(t+3<NT),(t+1<NT),(t+1<NT));       ENDW(t);   RESC(); ROT();
    STEP(pA0,pA1,pB0,pB1,t+1,(t+4<NT),(t+2<NT),(t+2<NT));     ENDW(t+1); RESC(); ROT();
  }
  STEP(pB0,pB1,pA0,pA1,NT-1,false,false,false); RESC();
  { float sacc=pB0[0]+pB0[1]; _Pragma("unroll") for(int r=2;r<16;++r)sacc+=pB0[r]; _Pragma("unroll") for(int r=0;r<16;++r)sacc+=pB1[r]; l_reg+=sacc;
    pw0=(u32x4){PKW(pB0,0),PKW(pB0,2),PKW(pB0,4),PKW(pB0,6)};pw1=(u32x4){PKW(pB0,8),PKW(pB0,10),PKW(pB0,12),PKW(pB0,14)};pw2=(u32x4){PKW(pB1,0),PKW(pB1,2),PKW(pB1,4),PKW(pB1,6)};pw3=(u32x4){PKW(pB1,8),PKW(pB1,10),PKW(pB1,12),PKW(pB1,14)};
    SBAR(); pv(o,vb0+sl_cur,PAF(0),PAF(1),PAF(2),PAF(3)); }
  #undef PKW
  #undef PAF
  #undef VFR
  #undef PIN
  #undef MX3
  #undef GAPA
  #undef GAPB
  #undef EX
  #undef VRD
  #undef KRD
  #undef STEP
  #undef ENDW
  {auto rr=__builtin_amdgcn_permlane32_swap(__float_as_uint(l_reg),__float_as_uint(l_reg),false,false);l_reg=__uint_as_float(rr[0])+__uint_as_float(rr[1]);}
  if(hi==0)wsf[32+r32]=l_reg;asm volatile("s_waitcnt lgkmcnt(0)":::"memory");
  float rli[16];
  #pragma unroll
  for(int r=0;r<16;++r)rli[r]=__builtin_amdgcn_rcpf(wsf[32+crow(r,hi)]);
  bf16*Ow=O+(rowbase+q0+wid*QBLK)*ADM+h*D;
  { bf16*stg=(bf16*)(shm+LDS_OST)+wid*2048;
    #pragma unroll
    for(int r=0;r<16;++r){const int orow=crow(r,hi);
      #pragma unroll
      for(int d0=0;d0<2;++d0){ const unsigned w=cvtpk_s(o[d0][r]*rli[r],0.f); stg[orow*64+d0*32+r32]=(bf16)(w&0xffffu); } }
    asm volatile("s_waitcnt lgkmcnt(0)":::"memory");
    #pragma unroll
    for(int i=0;i<4;++i){const int row=i*8+(lane>>3),ch=lane&7; const u32x4 v=*(const u32x4*)(stg+row*64+ch*8); *(u32x4*)(Ow+(long)row*ADM+ch*8)=v;} }
  asm volatile("s_waitcnt lgkmcnt(0)\n\ts_barrier":::"memory");
  #undef DMA_K
  #undef DMA_V
  #undef CMASK
  #undef START
  #undef RESC
  #undef ROT
}
#undef FLD
#undef SBAR
#undef WAIT_BAR
}

template <int N> __device__ __forceinline__ int dpp_ror_i(int x) { return __builtin_amdgcn_update_dpp(0, x, 0x120 + N, 0xf, 0xf, false); }
template <int N> __device__ __forceinline__ float dpp_ror_f(float x) { return __builtin_bit_cast(float, __builtin_amdgcn_update_dpp(0, __builtin_bit_cast(int, x), 0x120 + N, 0xf, 0xf, false)); }
template <int N> struct RankStep {
    static __device__ __forceinline__ void run(float v0, float v1, int fr, int& rank0, int& rank1) {
        const float ov0 = dpp_ror_f<N>(v0), ov1 = dpp_ror_f<N>(v1); const bool lower = dpp_ror_i<N>(fr) < fr;
        rank0 += ((ov0 > v0 || (ov0 == v0 && lower)) ? 1 : 0) + ((ov1 > v0) ? 1 : 0);
        rank1 += ((ov0 >= v1) ? 1 : 0) + ((ov1 > v1 || (ov1 == v1 && lower)) ? 1 : 0);
        RankStep<N + 1>::run(v0, v1, fr, rank0, rank1); } };
template <> struct RankStep<16> { static __device__ __forceinline__ void run(float, float, int, int&, int&) {} };
__global__ void __launch_bounds__(NTHR, 2) fwd_kernel(Args A) {
    extern __shared__ __attribute__((aligned(16))) unsigned char lds_raw[];
    LAS unsigned char* lds = (LAS unsigned char*)lds_raw;
    volatile LAS unsigned* MISC = (volatile LAS unsigned*)(lds + MISC_OFF);
    const int tid = threadIdx.x, lane = tid & 63, wave = __builtin_amdgcn_readfirstlane(tid >> 6);
    const int G = gridDim.x, bid = blockIdx.x;
    const int gw = bid * NWAVES + wave, NGW = G * NWAVES;
    unsigned char* ws = A.ws;
    unsigned* ctl = (unsigned*)(ws + WS_CTL);
    float* modp = (float*)(ws + WS_MODP); float* modf = (float*)(ws + WS_MODF); float* Wfc = (float*)(ws + WS_WFC); unsigned char* WRAg = ws + WS_WRA; float* cstp = (float*)(ws + WS_CSTP);
    float* lcb = (float*)(ws + WS_LC); float* totb = (float*)(ws + WS_TOT);
    bf16* Win_t = (bf16*)(ws + WS_WIN); bf16* Wout_t = (bf16*)(ws + WS_WOUT); unsigned char* Wgu8 = ws + WS_WGU; unsigned char* Wd8 = ws + WS_WD;
    bf16* Hb = (bf16*)(ws + WS_H); bf16* Qb = (bf16*)(ws + WS_Q); bf16* Kb = (bf16*)(ws + WS_K); bf16* Vb = (bf16*)(ws + WS_V); bf16* Ob = (bf16*)(ws + WS_O);
    bf16* GBb = (bf16*)(ws + WS_GB); bf16* CUb = (bf16*)(ws + WS_CU); bf16* MIXb = (bf16*)(ws + WS_MIX); bf16* DELTAb = (bf16*)(ws + WS_GB);
    int* tokslot = (int*)(ws + WS_TOKSLOT); int* rowtok = (int*)(ws + WS_ROWTOK); float* roww = (float*)(ws + WS_ROWW);
    unsigned char* ACT8 = ws + WS_ACT; unsigned char* Y8 = ws + WS_Y; unsigned char* H8 = ws + WS_H;
    unsigned* gcnt = ctl + CW_CNT;

    for (int u = tid; u < 128; u += NTHR) MISC[u] = 0u;
    __syncthreads();
    XcdBarrier bar = xcd_barrier_post(ctl + CW_BAR, MISC + 8);

    {
        const int tid = opaque_tid(), lane = tid & 63, wave = __builtin_amdgcn_readfirstlane(tid >> 6), gw = bid * NWAVES + wave; (void)lane; (void)gw;
        LAS float* silu_tab = (LAS float*)lds;
        for (int i = tid; i < NB * DM; i += NTHR) { const int b = i / DM, k = i % DM; silu_tab[k * 8 + b] = siluf(A.c[i]); }
        __syncthreads();
        if (bid == G - 1) { for (int i = wave * 1024 + lane; i < wave * 1024 + 1024; i += 64) Wfc[i] = A.w_in[(size_t)(i >> 3) * NIN + COL_F + (i & 7)]; }
        if (gw % 5 == 0 && gw / 5 < 384) {
            const int it = gw / 5, cg = it >> 2, ks = it & 3, col = 64 * cg + lane;
            float acc[8] = {0.f, 0.f, 0.f, 0.f, 0.f, 0.f, 0.f, 0.f};
            const float* wp = A.w_ada + (size_t)(256 * ks) * NMOD + col;
#pragma unroll 1
            for (int k0 = 0; k0 < 256; k0 += 16) { float w[16];
#pragma unroll
                for (int k = 0; k < 16; ++k) w[k] = __builtin_nontemporal_load(wp + (size_t)(k0 + k) * NMOD);
#pragma unroll
                for (int k = 0; k < 16; ++k) { const f32x4 s0 = *(const LAS f32x4*)(silu_tab + (256 * ks + k0 + k) * 8), s1 = *(const LAS f32x4*)(silu_tab + (256 * ks + k0 + k) * 8 + 4);
                    acc[0] += s0[0] * w[k]; acc[1] += s0[1] * w[k]; acc[2] += s0[2] * w[k]; acc[3] += s0[3] * w[k]; acc[4] += s1[0] * w[k]; acc[5] += s1[1] * w[k]; acc[6] += s1[2] * w[k]; acc[7] += s1[3] * w[k]; } }
#pragma unroll
            for (int b = 0; b < 8; ++b) modp[(size_t)(ks * 8 + b) * NMOD + col] = acc[b];
        }
        { const int tid = opaque_tid(), lane = tid & 63; (void)tid;
        LAS unsigned* scr = (LAS unsigned*)(lds + 32768 + wave * 4352);
        constexpr int I_IN = 96 * 16, I_OUT = 32 * 16, NITEMS = I_IN + I_OUT;
        constexpr int I_GU = NE * 64 * 8, I_D = NE * 32 * 8, NITEMS8 = I_GU + I_D;
        for (int it = gw; it < NITEMS; it += NGW) {
            TItem ti; int r = it;
            if (r < I_IN) { const int g = r >> 4, kb = r & 15; ti = TItem{A.w_in + (size_t)(64 * kb) * NIN + win_src_col(g), Win_t + (size_t)(32 * g) * DM + 64 * kb, NIN, DM}; }
            else { r -= I_IN; const int g = r >> 4, kb = r & 15; ti = TItem{A.w_out + (size_t)(64 * kb) * DM + 32 * g, Wout_t + (size_t)(32 * g) * DM + 64 * kb, DM, DM}; }
            f32x4 va[8]; titem_load(ti, lane, va); titem_store(ti, lane, va, scr);
        }
        auto decode8 = [&](int it) -> TItem8 {
            int r = it;
            if (r < I_GU) { const int e = r >> 9, g = (r >> 3) & 63, kb = r & 7; const int pn = g >> 3, p0 = (g & 7) * 32, bj = p0 >> 7, wc = (p0 >> 5) & 3;
                return TItem8{A.w_gate_up + (size_t)e * DM * 2 * DE + (size_t)(128 * kb) * 2 * DE + (bj ? DE : 0) + 128 * pn + 32 * wc, Wgu8 + ((size_t)e * 2 * DE + 32 * g) * DM + 128 * kb, 2 * DE, DM}; }
            r -= I_GU;
            { const int e = r >> 8, g = (r >> 3) & 31, kb = r & 7;
                return TItem8{A.w_down + (size_t)e * DE * DM + (size_t)(128 * kb) * DM + 32 * g, Wd8 + ((size_t)e * DM + 32 * g) * DE + 128 * kb, DM, DE}; }
        };
        if (gw < NITEMS8) {
            f32x4 va[16], vb[16]; TItem8 ta = decode8(gw), tb = ta;
            titem8_load(ta, lane, va);
            for (int it = gw; it < NITEMS8; it += 2 * NGW) {
                if (it + NGW < NITEMS8) { tb = decode8(it + NGW); titem8_load(tb, lane, vb); }
                titem8_store(ta, lane, va, scr);
                if (it + NGW < NITEMS8) {
                    if (it + 2 * NGW < NITEMS8) { ta = decode8(it + 2 * NGW); titem8_load(ta, lane, va); }
                    titem8_store(tb, lane, vb, scr);
                }
            }
        }
        }
    }
    xcd_barrier(bar);

    {
        const int tid = opaque_tid(), lane = tid & 63, wave = __builtin_amdgcn_readfirstlane(tid >> 6), gw = bid * NWAVES + wave; (void)lane; (void)gw;
        LAS float* tabA = (LAS float*)lds; LAS float* tabB = tabA + DM; LAS f32x4* Wf4 = (LAS f32x4*)(tabB + DM)  ; LAS float* lfs = (LAS float*)(Wf4 + 2 * DM)  ;
        for (int rb = bid; rb < T / 64; rb += G) {
            const int b = rb / (SEQ / 64);
            f32x4 v[8][4];
#pragma unroll
            for (int i = 0; i < 8; ++i) { const f32x4* xr = (const f32x4*)(A.x + (size_t)(rb * 64 + wave * 8 + i) * DM) + lane;
#pragma unroll
                for (int j = 0; j < 4; ++j) v[i][j] = __builtin_nontemporal_load(xr + 64 * j); }
            if (tid < DM / 4) {
                const int k = 4 * tid; f32x4 sh = *(const f32x4*)(A.b_ada + k), sc = *(const f32x4*)(A.b_ada + DM + k);
#pragma unroll
                for (int p = 0; p < 4; ++p) { sh += *(const f32x4*)(modp + (size_t)(p * 8 + b) * NMOD + k); sc += *(const f32x4*)(modp + (size_t)(p * 8 + b) * NMOD + DM + k); }
                const f32x4 nw = *(const f32x4*)(A.norm1_w + k);
                *(LAS f32x4*)(tabA + k) = nw * (1.f + sc); *(LAS f32x4*)(tabB + k) = sh; }
            else { const int k = tid - DM / 4;
#pragma unroll
                for (int q = 0; q < 4; ++q) { const int kk = k + 256 * q; const int prow = (kk & ~63) | ((kk & 3) << 4) | ((kk >> 2) & 15);
                    Wf4[prow] = *(const f32x4*)(Wfc + kk * 8); Wf4[DM + prow] = *(const f32x4*)(Wfc + kk * 8 + 4); } }
            for (int i = bid * NTHR + tid; i < NB * NMOD / 4; i += G * NTHR) { const int bb = (4 * i) / NMOD, j = (4 * i) % NMOD; f32x4 s = *(const f32x4*)(A.b_ada + j);
#pragma unroll
                for (int p = 0; p < 4; ++p) s += *(const f32x4*)(modp + (size_t)(p * 8 + bb) * NMOD + j);
                *(f32x4*)(modf + 4 * (size_t)i) = s; }
            __syncthreads();
            const float bfg = A.b_forget[(lane >> 3) & 7];
#pragma unroll
            for (int i = 0; i < 8; ++i) {
                const int rl = wave * 8 + i, row = rb * 64 + rl;
                float ss = 0.f;
#pragma unroll
                for (int j = 0; j < 4; ++j) ss += (v[i][j][0] * v[i][j][0] + v[i][j][1] * v[i][j][1]) + (v[i][j][2] * v[i][j][2] + v[i][j][3] * v[i][j][3]);
                const float rstd = rsqrtf(wave_sum(ss) * (1.f / DM) + EPS);
                float fa[8] = {0.f, 0.f, 0.f, 0.f, 0.f, 0.f, 0.f, 0.f};
                u32x2* o8 = (u32x2*)(Hb + (size_t)row * DM) + lane;
#pragma unroll
                for (int j = 0; j < 4; ++j) { const int k4 = lane + 64 * j; const f32x4 a = *(const LAS f32x4*)(tabA + 4 * k4), bb = *(const LAS f32x4*)(tabB + 4 * k4);
                    const f32x4 h = v[i][j] * rstd * a + bb;
                    u32x2 o; o.x = cvtpk(h[0], h[1]); o.y = cvtpk(h[2], h[3]); o8[64 * j] = o;
#pragma unroll
                    for (int c = 0; c < 4; ++c) { const int prow = 256 * j + 64 * (lane >> 4) + 16 * c + (lane & 15); const f32x4 w0 = Wf4[prow], w1 = Wf4[DM + prow];
                        fa[0] += h[c] * w0[0]; fa[1] += h[c] * w0[1]; fa[2] += h[c] * w0[2]; fa[3] += h[c] * w0[3]; fa[4] += h[c] * w1[0]; fa[5] += h[c] * w1[1]; fa[6] += h[c] * w1[2]; fa[7] += h[c] * w1[3]; } }
                { const bool u5 = (lane & 32) != 0, u4 = (lane & 16) != 0, u3 = (lane & 8) != 0;
#pragma unroll
                  for (int q = 0; q < 4; ++q) { const float lo = fa[q], hi = fa[q + 4]; fa[q] = (u5 ? hi : lo) + __shfl_xor(u5 ? lo : hi, 32); }
#pragma unroll
                  for (int q = 0; q < 2; ++q) { const float lo = fa[q], hi = fa[q + 2]; fa[q] = (u4 ? hi : lo) + __shfl_xor(u4 ? lo : hi, 16); }
                  { const float lo = fa[0], hi = fa[1]; fa[0] = (u3 ? hi : lo) + __shfl_xor(u3 ? lo : hi, 8); }
                  fa[0] += __shfl_xor(fa[0], 4); fa[0] += __shfl_xor(fa[0], 2); fa[0] += __shfl_xor(fa[0], 1); }
                if ((lane & 7) == 0) { const float z = fa[0] + bfg; const float ls = (z < 0.f) ? (z - log1pf(__expf(z))) : (-log1pf(__expf(-z))); lfs[rl * 8 + ((lane >> 3) & 7)] = ls * LOG2E; }
            }
            __syncthreads();
            if (wave == 0) {
                const int sb = rb % (SEQ / 64);
#pragma unroll
                for (int j = 0; j < 8; ++j) { float s = lfs[lane * 8 + j];
#pragma unroll
                    for (int o = 1; o < 64; o <<= 1) { const float t = __shfl_up(s, o); if (lane >= o) s += t; }
                    lcb[(size_t)(b * NH + j) * SEQ + sb * 64 + lane] = s; if (lane == 63) totb[(b * NH + j) * 32 + sb] = s; }
            }
            { const int bq = rb >> 5, ks = rb & 31; LAS float* red = lfs + 512;
              if (tid < 256) { const int k = 32 * ks + (tid >> 3), c4 = tid & 7; const int i4 = 4 * DM + k, i3 = 3 * DM + k;
                  float sc = A.b_ada[i4], sh = A.b_ada[i3];
#pragma unroll
                  for (int p = 0; p < 4; ++p) { sc += modp[(size_t)(p * 8 + bq) * NMOD + i4]; sh += modp[(size_t)(p * 8 + bq) * NMOD + i3]; }
                  const float a = A.norm2_w[k] * (1.f + sc); const f32x4 w = *(const f32x4*)(A.w_router + (size_t)k * NE + 4 * c4);
                  unsigned char* wp = WRAg + (size_t)bq * 65536 + ((c4 >> 2) * 32 + ks) * 1024 + ((((k >> 3) & 3) * 16 + 4 * (c4 & 3))) * 16 + (k & 7) * 2;
#pragma unroll
                  for (int q = 0; q < 4; ++q) *(unsigned short*)(wp + 16 * q) = (unsigned short)(cvtpk(w[q] * a, 0.f) & 0xffffu);
                  *(LAS f32x4*)(red + 4 * tid) = w * sh; }
              __syncthreads();
              if (tid < 32) { const int c4 = tid >> 2, q = tid & 3; float s = 0.f; for (int t2 = 0; t2 < 32; ++t2) s += red[4 * (8 * t2 + c4) + q]; cstp[((size_t)bq * 32 + ks) * 32 + tid] = s; } }
            __syncthreads();
        }
    }
    xcd_barrier(bar);

    {
        const int tid = opaque_tid(), lane = tid & 63, wave = __builtin_amdgcn_readfirstlane(tid >> 6), gw = bid * NWAVES + wave; (void)lane; (void)gw;
        EpiInProj E{Qb, Kb, Vb, GBb, CUb, A.q_norm_w, A.k_norm_w};
        StaticOrder S; S.init(T, 3072, DM, G, bid);
        gemm_phase<EpiInProj, StaticOrder, true>(lds, Hb, Win_t, DM, S, E);
    }
    xcd_barrier(bar);

    {
        const int tid = opaque_tid(), lane = tid & 63, wave = __builtin_amdgcn_readfirstlane(tid >> 6), gw = bid * NWAVES + wave; (void)lane; (void)gw;
        char* shm = (char*)lds_raw;
        LAS float* FL = (LAS float*)(lds + attn_body::LDS_FL);
        const int vcu = (G % 8 == 0) ? (bid % 8) * (G / 8) + bid / 8 : bid;
        for (int v = vcu; v < 256; v += G) {
            const int bh = v >> 2, s = v & 3, b = bh >> 3, h = bh & 7;
            { float pre = 0.f; const float tv = (lane < 32) ? totb[bh * 32 + lane] : 0.f; float sc = tv;
#pragma unroll
              for (int o = 1; o < 32; o <<= 1) { const float t2 = __shfl_up(sc, o); if (lane >= o) sc += t2; }
              sc -= tv;
              for (int i = 0; i < 4; ++i) { const int t = tid + NTHR * i; pre = __shfl(sc, t >> 6); FL[t] = pre + lcb[(size_t)bh * SEQ + t]; } }
            VM_WAIT(); __syncthreads();
            attn_body::attn_unit<8>(b, h, s, Qb, Kb, Vb, Ob, shm);
            attn_body::attn_unit<8>(b, h, 7 - s, Qb, Kb, Vb, Ob, shm);
            __syncthreads();
        }
    }
    xcd_barrier(bar);

    {
        const int tid = opaque_tid(), lane = tid & 63, wave = __builtin_amdgcn_readfirstlane(tid >> 6), gw = bid * NWAVES + wave; (void)lane; (void)gw;
        float cw[3][8], wa[8], wcn[8];
#pragma unroll
        for (int i = 0; i < 8; ++i) { cw[0][i] = A.conv_w[0 * DC + 8 * lane + i]; cw[1][i] = A.conv_w[1 * DC + 8 * lane + i]; cw[2][i] = A.conv_w[2 * DC + 8 * lane + i];
            wa[i] = A.attn_out_norm_w[8 * lane + i]; wcn[i] = A.conv_out_norm_w[8 * lane + i]; }
        for (int rg = gw; rg < T / 8; rg += NGW) {
            const int r0 = rg * 8; const bool head = (r0 % SEQ) == 0;
            u32x4 ow[8], gbw[8], cu[10];
            const u32x4 zero = {0u, 0u, 0u, 0u};
#pragma unroll
            for (int i = 0; i < 8; ++i) { ow[i] = __builtin_nontemporal_load((const u32x4*)(Ob + (size_t)(r0 + i) * DA + 8 * lane)); gbw[i] = __builtin_nontemporal_load((const u32x4*)(GBb + (size_t)(r0 + i) * DC + 8 * lane)); cu[i + 2] = *(const u32x4*)(CUb + (size_t)(r0 + i) * DC + 8 * lane); }
            cu[0] = head ? zero : *(const u32x4*)(CUb + (size_t)(r0 - 2) * DC + 8 * lane); cu[1] = head ? zero : *(const u32x4*)(CUb + (size_t)(r0 - 1) * DC + 8 * lane);
#pragma unroll
            for (int r = 0; r < 8; ++r) {
                float a[8], y[8]; float ssa = 0.f, ssc = 0.f;
#pragma unroll
                for (int i = 0; i < 4; ++i) { const unsigned w_o = ow[r][i], w_g = gbw[r][i], w0 = cu[r + 2][i], w1 = cu[r + 1][i], w2 = cu[r][i];
                    a[2 * i] = bf_lo(w_o); a[2 * i + 1] = bf_hi(w_o);
                    y[2 * i] = bf_lo(w_g) * (cw[0][2 * i] * bf_lo(w2) + cw[1][2 * i] * bf_lo(w1) + cw[2][2 * i] * bf_lo(w0));
                    y[2 * i + 1] = bf_hi(w_g) * (cw[0][2 * i + 1] * bf_hi(w2) + cw[1][2 * i + 1] * bf_hi(w1) + cw[2][2 * i + 1] * bf_hi(w0)); }
#pragma unroll
                for (int i = 0; i < 8; ++i) { ssa += a[i] * a[i]; ssc += y[i] * y[i]; }
                const float ra = rsqrtf(wave_sum(ssa) * (1.f / DA) + EPS), rc = rsqrtf(wave_sum(ssc) * (1.f / DC) + EPS);
                u32x4 oa, oc;
                oa.x = cvtpk(a[0] * ra * wa[0], a[1] * ra * wa[1]); oa.y = cvtpk(a[2] * ra * wa[2], a[3] * ra * wa[3]); oa.z = cvtpk(a[4] * ra * wa[4], a[5] * ra * wa[5]); oa.w = cvtpk(a[6] * ra * wa[6], a[7] * ra * wa[7]);
                oc.x = cvtpk(y[0] * rc * wcn[0], y[1] * rc * wcn[1]); oc.y = cvtpk(y[2] * rc * wcn[2], y[3] * rc * wcn[3]); oc.z = cvtpk(y[4] * rc * wcn[4], y[5] * rc * wcn[5]); oc.w = cvtpk(y[6] * rc * wcn[6], y[7] * rc * wcn[7]);
                store16_wt(MIXb + (size_t)(r0 + r) * DM + 8 * lane, oa); store16_wt(MIXb + (size_t)(r0 + r) * DM + DA + 8 * lane, oc);
            }
        }
    }
    xcd_barrier(bar);

    {
        const int tid = opaque_tid(), lane = tid & 63, wave = __builtin_amdgcn_readfirstlane(tid >> 6), gw = bid * NWAVES + wave; (void)lane; (void)gw;
        EpiOutProj E{DELTAb, modf};
        StaticOrder S; S.init(T, DM, DM, G, bid);
        gemm_phase<EpiOutProj, StaticOrder, false>(lds, MIXb, Wout_t, DM, S, E);
    }
    xcd_barrier(bar);

    {
        const int tid = opaque_tid(), lane = tid & 63, wave = __builtin_amdgcn_readfirstlane(tid >> 6), gw = bid * NWAVES + wave; (void)lane; (void)gw;
        LAS unsigned char* WRA = lds; LAS unsigned char* XT = lds + 65536;
        LAS float* tabA = (LAS float*)(lds + 131072); LAS float* tabB = tabA + DM;
        LAS float* cst = tabB + DM  ; LAS float* rstdv = cst + 32  ;
        LAS int* lcnt = (LAS int*)(rstdv + 64); LAS int* lbase = lcnt + 32; LAS int* asg_e = lbase + 32; LAS int* asg_r = asg_e + 256; LAS float* asg_w = (LAS float*)(asg_r + 256);
        for (int rb = bid; rb < T / 64; rb += G) {
            const int tid = opaque_tid(), lane = tid & 63;
            const int b = rb / (SEQ / 64);
            f32x4 v[8][4];
#pragma unroll
            for (int r = 0; r < 8; ++r) { const size_t ro = (size_t)(rb * 64 + wave * 8 + r) * DM; const f32x4* xr = (const f32x4*)(A.x + ro) + lane; const u32x2* dr = (const u32x2*)(DELTAb + ro) + lane;
#pragma unroll
                for (int j = 0; j < 4; ++j) { const f32x4 xv = __builtin_nontemporal_load(xr + 64 * j); const u32x2 dv = dr[64 * j];
                    v[r][j] = xv + (f32x4){bf_lo(dv.x), bf_hi(dv.x), bf_lo(dv.y), bf_hi(dv.y)}; } }
            if (tid < DM / 4) { const int k = 4 * tid; *(LAS f32x4*)(tabA + k) = *(const f32x4*)(A.norm2_w + k) * (1.f + *(const f32x4*)(modf + (size_t)b * NMOD + 4 * DM + k)); *(LAS f32x4*)(tabB + k) = *(const f32x4*)(modf + (size_t)b * NMOD + 3 * DM + k); }
            if (tid < 32) lcnt[tid] = 0;
            __syncthreads();
#pragma unroll
            for (int p = 0; p < 8; ++p) __builtin_amdgcn_global_load_lds((const unsigned*)(WRAg + (size_t)b * 65536 + (wave * 8 + p) * 1024 + lane * 16), (LAS unsigned*)(WRA + (wave * 8 + p) * 1024), 16, 0, 0);
            if (tid < 32) { float s = A.b_router[tid]; for (int t2 = 0; t2 < 32; ++t2) s += cstp[((size_t)b * 32 + t2) * 32 + tid]; cst[tid] = s; }
            VM_WAIT();
            float rstd[8];
#pragma unroll
            for (int r = 0; r < 8; ++r) { float ss = 0.f;
#pragma unroll
                for (int j = 0; j < 4; ++j) ss += (v[r][j][0] * v[r][j][0] + v[r][j][1] * v[r][j][1]) + (v[r][j][2] * v[r][j][2] + v[r][j][3] * v[r][j][3]);
                rstd[r] = rsqrtf(wave_sum(ss) * (1.f / DM) + EPS); if (lane == 0) rstdv[wave * 8 + r] = rstd[r]; }
#pragma unroll
            for (int j = 0; j < 4; ++j) { const int k4 = lane + 64 * j; const f32x4 a = *(const LAS f32x4*)(tabA + 4 * k4), bb = *(const LAS f32x4*)(tabB + 4 * k4);
#pragma unroll
                for (int r = 0; r < 8; ++r) { const f32x4 h = v[r][j] * rstd[r] * a + bb; ((unsigned*)(H8 + (size_t)(rb * 64 + wave * 8 + r) * DM))[k4] = pack4_fp8(h[0], h[1], h[2], h[3]); } }
            f32x4 acc0 = {0.f, 0.f, 0.f, 0.f}, acc1 = {0.f, 0.f, 0.f, 0.f};
            const int fr = lane & 15, fq = lane >> 4;
            const int wsp = lane >> 3, wfq = (lane >> 1) & 3, wh8 = lane & 1, wfr0 = 8 * (wave & 1), wc = wfq | ((wsp & 1) ? 12 : 0);
            LAS unsigned char* wbase = XT + (((wave >> 1) * 8 + wsp) * 2) * 1024 + wfq * 256 + 8 * wh8;
            const LAS unsigned char* rbase_e = XT + (wave & 3) * 16384 + fq * 256 + (fr ^ fq) * 16;
            const LAS unsigned char* rbase_o = XT + (wave & 3) * 16384 + fq * 256 + (fr ^ (fq | 12)) * 16;
#pragma unroll
            for (int j = 0; j < 4; ++j) {
                __syncthreads();
#pragma unroll
                for (int r = 0; r < 8; ++r) { const f32x4 x = v[r][j];
                    u32x2 hi; hi.x = cvtpk(x[0], x[1]); hi.y = cvtpk(x[2], x[3]);
                    u32x2 lo; lo.x = cvtpk(x[0] - bf_lo(hi.x), x[1] - bf_hi(hi.x)); lo.y = cvtpk(x[2] - bf_lo(hi.y), x[3] - bf_hi(hi.y));
                    LAS unsigned char* p = wbase + ((wfr0 + r) ^ wc) * 16; *(LAS u32x2*)p = hi; *(LAS u32x2*)(p + 1024) = lo; }
                __syncthreads();
                if (wave < 4) {
#pragma unroll
                    for (int ks = 0; ks < 8; ++ks) { const LAS unsigned char* ap = ((ks & 1) ? rbase_o : rbase_e) + ks * 2048;
                        const bf16x8 ahi = *(const LAS bf16x8*)ap, alo = *(const LAS bf16x8*)(ap + 1024);
                        const bf16x8 b0 = *(const LAS bf16x8*)(WRA + (8 * j + ks) * 1024 + lane * 16), b1 = *(const LAS bf16x8*)(WRA + (32 + 8 * j + ks) * 1024 + lane * 16);
                        acc0 = __builtin_amdgcn_mfma_f32_16x16x32_bf16(ahi, b0, acc0, 0, 0, 0); acc0 = __builtin_amdgcn_mfma_f32_16x16x32_bf16(alo, b0, acc0, 0, 0, 0);
                        acc1 = __builtin_amdgcn_mfma_f32_16x16x32_bf16(ahi, b1, acc1, 0, 0, 0); acc1 = __builtin_amdgcn_mfma_f32_16x16x32_bf16(alo, b1, acc1, 0, 0, 0); }
                }
            }
            if (wave < 4) {
                const float c0 = cst[fr], c1 = cst[16 + fr];
#pragma unroll
                for (int reg = 0; reg < 4; ++reg) {
                    const int rl = 16 * wave + 4 * fq + reg; const float rs = rstdv[rl];
                    const float v0 = acc0[reg] * rs + c0, v1 = acc1[reg] * rs + c1;
                    int rank0 = (v1 > v0) ? 1 : 0, rank1 = (v0 >= v1) ? 1 : 0;
                    RankStep<1>::run(v0, v1, fr, rank0, rank1);
                    const bool sel0 = rank0 < 4, sel1 = rank1 < 4;
                    float m = fmaxf(v0, v1), ps;
                    m = fmaxf(m, dpp_ror_f<8>(m)); m = fmaxf(m, dpp_ror_f<4>(m)); m = fmaxf(m, dpp_ror_f<2>(m)); m = fmaxf(m, dpp_ror_f<1>(m));
                    const float p0 = sel0 ? __expf(v0 - m) : 0.f, p1 = sel1 ? __expf(v1 - m) : 0.f;
                    ps = p0 + p1;
                    ps += dpp_ror_f<8>(ps); ps += dpp_ror_f<4>(ps); ps += dpp_ror_f<2>(ps); ps += dpp_ror_f<1>(ps);
                    const float inv = 1.f / ps;
                    const unsigned g0 = (unsigned)(__ballot(sel0) >> (16 * fq)) & 0xffffu, g1 = (unsigned)(__ballot(sel1) >> (16 * fq)) & 0xffffu;
                    const unsigned below = (1u << fr) - 1u;
                    if (sel0) { const int k = __popc(g0 & below); const int rk = __hip_atomic_fetch_add(lcnt + fr, 1, __ATOMIC_RELAXED, __HIP_MEMORY_SCOPE_WORKGROUP);
                        asg_e[rl * 4 + k] = fr; asg_r[rl * 4 + k] = rk; asg_w[rl * 4 + k] = p0 * inv; }
                    if (sel1) { const int k = __popc(g0) + __popc(g1 & below); const int rk = __hip_atomic_fetch_add(lcnt + 16 + fr, 1, __ATOMIC_RELAXED, __HIP_MEMORY_SCOPE_WORKGROUP);
                        asg_e[rl * 4 + k] = 16 + fr; asg_r[rl * 4 + k] = rk; asg_w[rl * 4 + k] = p1 * inv; }
                }
            }
            __syncthreads();
            if (tid < 32) { const int n = lcnt[tid]; lbase[tid] = n ? (int)__hip_atomic_fetch_add(gcnt + 16 * tid, (unsigned)n, __ATOMIC_RELAXED, __HIP_MEMORY_SCOPE_AGENT) : 0; }
            __syncthreads();
            if (tid < 256) { const int e2 = asg_e[tid], rank = lbase[e2] + asg_r[tid], tok = rb * 64 + (tid >> 2);
                rowtok[(size_t)e2 * ECAP + rank] = tok; roww[(size_t)e2 * ECAP + rank] = asg_w[tid]; tokslot[tok * 4 + (tid & 3)] = (e2 << 16) | rank; }
            __syncthreads();
        }
    }
    xcd_barrier(bar);

    LAS int* ecnt = (LAS int*)(lds + MISC_OFF - 4096); LAS int* etile0 = ecnt + 32; LAS int* tile_e = etile0 + 33;
    if (tid < 64) {
        const int e = tid & 31; const int n = (int)__hip_atomic_load(gcnt + 16 * e, __ATOMIC_RELAXED, __HIP_MEMORY_SCOPE_AGENT); const int nt = (n + 255) >> 8;
        int inc = nt;
#pragma unroll
        for (int o = 1; o < 32; o <<= 1) { const int t2 = __shfl_up(inc, o, 32); if (e >= o) inc += t2; }
        const int base = inc - nt;
        if (tid < 32) { ecnt[e] = n; etile0[e] = base; for (int q = 0; q < nt; ++q) tile_e[base + q] = e; if (e == 31) etile0[NE] = inc; }
    }
    __syncthreads();
    const int MT = etile0[NE];

    {
        const int tid = opaque_tid(), lane = tid & 63, wave = __builtin_amdgcn_readfirstlane(tid >> 6), gw = bid * NWAVES + wave; (void)lane; (void)gw;
        LAS unsigned short* tokl = (LAS unsigned short*)(lds + 131072);
        MoeOrder<true> S; S.init(MT, 8, DM, G, bid, tile_e, tokl);
        { Unit u; for (int i = 0; S.next(i, u); ++i) { if (tid < 256) { const int e = u.pn >> 3, lt = u.pm - etile0[e], rank = lt * 256 + tid; tokl[i * 256 + tid] = (unsigned short)((rank < ecnt[e]) ? rowtok[(size_t)e * ECAP + rank] : 0); } } }
        __syncthreads();
        EpiGate E{ACT8, A.b_gate_up};
        gemm_phase_f8<EpiGate, MoeOrder<true>, true>(lds, H8, Wgu8, DM, S, E);
    }
    xcd_barrier(bar);

    {
        const int tid = opaque_tid(), lane = tid & 63, wave = __builtin_amdgcn_readfirstlane(tid >> 6), gw = bid * NWAVES + wave; (void)lane; (void)gw;
        MoeOrder<false> S; S.init(MT, 4, DE, G, bid, tile_e, nullptr);
        EpiDown E{Y8, A.b_down, roww, ecnt, etile0};
        gemm_phase_f8<EpiDown, MoeOrder<false>, true>(lds, ACT8, Wd8, DE, S, E);
    }
    xcd_barrier(bar);

    {
        const int tid = opaque_tid(), lane = tid & 63, wave = __builtin_amdgcn_readfirstlane(tid >> 6), gw = bid * NWAVES + wave; (void)lane; (void)gw;
        for (int rg = gw; rg < T / 8; rg += NGW) {
            const int r0 = rg * 8, b = r0 / SEQ;
            int slotv = 0;
            if (lane < 32) { const int ts = tokslot[r0 * 4 + lane]; slotv = etile0[ts >> 16] * 256 + (ts & 0xffff); }
            f32x4 g2v[2][2];
#pragma unroll
            for (int j = 0; j < 2; ++j) { g2v[j][0] = *(const f32x4*)(modf + (size_t)b * NMOD + 5 * DM + 512 * j + 8 * lane) * (1.f / YSCALE); g2v[j][1] = *(const f32x4*)(modf + (size_t)b * NMOD + 5 * DM + 512 * j + 8 * lane + 4) * (1.f / YSCALE); }
#pragma unroll 1
            for (int p = 0; p < 4; ++p) {
                u32x2 yw[2][4][2]; f32x4 xv[2][2][2];
#pragma unroll
                for (int r = 0; r < 2; ++r) { const int row = r0 + 2 * p + r;
#pragma unroll
                    for (int k = 0; k < 4; ++k) { const int sl = __shfl(slotv, 4 * (2 * p + r) + k);
#pragma unroll
                        for (int j = 0; j < 2; ++j) yw[r][k][j] = __builtin_nontemporal_load((const u32x2*)(Y8 + (size_t)sl * DM + 512 * j + 8 * lane)); }
#pragma unroll
                    for (int j = 0; j < 2; ++j) { const size_t oo = (size_t)row * DM + 512 * j + 8 * lane; const u32x4 dv = __builtin_nontemporal_load((const u32x4*)(DELTAb + oo));
                        xv[r][j][0] = __builtin_nontemporal_load((const f32x4*)(A.x + oo)) + (f32x4){bf_lo(dv.x), bf_hi(dv.x), bf_lo(dv.y), bf_hi(dv.y)};
                        xv[r][j][1] = __builtin_nontemporal_load((const f32x4*)(A.x + oo + 4)) + (f32x4){bf_lo(dv.z), bf_hi(dv.z), bf_lo(dv.w), bf_hi(dv.w)}; } }
#pragma unroll
                for (int r = 0; r < 2; ++r) { const int row = r0 + 2 * p + r;
#pragma unroll
                    for (int j = 0; j < 2; ++j) { float s[8] = {0.f, 0.f, 0.f, 0.f, 0.f, 0.f, 0.f, 0.f};
#pragma unroll
                        for (int k = 0; k < 4; ++k) { const u32x2 w = yw[r][k][j];
                            const f32x2 a0 = __builtin_amdgcn_cvt_pk_f32_fp8((int)w.x, false), a1 = __builtin_amdgcn_cvt_pk_f32_fp8((int)w.x, true), a2 = __builtin_amdgcn_cvt_pk_f32_fp8((int)w.y, false), a3 = __builtin_amdgcn_cvt_pk_f32_fp8((int)w.y, true);
                            s[0] += a0[0]; s[1] += a0[1]; s[2] += a1[0]; s[3] += a1[1]; s[4] += a2[0]; s[5] += a2[1]; s[6] += a3[0]; s[7] += a3[1]; }
                        float* op = A.out + (size_t)row * DM + 512 * j + 8 * lane;
                        __builtin_nontemporal_store(xv[r][j][0] + g2v[j][0] * (f32x4){s[0], s[1], s[2], s[3]}, (f32x4*)op); __builtin_nontemporal_store(xv[r][j][1] + g2v[j][1] * (f32x4){s[4], s[5], s[6], s[7]}, (f32x4*)(op + 4)); } }
            }
        }
    }
}

extern "C" void kernel_launch(void* const* d_in, const int* in_sizes, int n_in, void* d_out, int out_size, void* d_ws, size_t ws_size, hipStream_t stream) {
    static int grid = 0;
    if (grid == 0) {
        if (n_in != 20 || out_size != T * DM || ws_size < WS_END) { fprintf(stderr, "kernel_launch: unexpected problem shape (n_in %d out %d ws %zu)\n", n_in, out_size, ws_size); grid = -1; return; }
        int dev = 0, cus = 0;
        if (hipGetDevice(&dev) != hipSuccess || hipDeviceGetAttribute(&cus, hipDeviceAttributeMultiprocessorCount, dev) != hipSuccess) { grid = -1; return; }
        if (hipFuncSetAttribute((const void*)fwd_kernel, hipFuncAttributeMaxDynamicSharedMemorySize, LDS_BYTES) != hipSuccess) { fprintf(stderr, "kernel_launch: hipFuncSetAttribute failed\n"); grid = -1; return; }
        int per_cu = 0;
        if (hipOccupancyMaxActiveBlocksPerMultiprocessor(&per_cu, (const void*)fwd_kernel, NTHR, LDS_BYTES) != hipSuccess || per_cu < 1) { fprintf(stderr, "kernel_launch: occupancy query says %d\n", per_cu); }
        (void)hipGetLastError();
        grid = cus;
    }
    if (grid < 0) return;
    if (hipMemsetAsync((char*)d_ws + WS_CTL, 0, CTL_ZERO_BYTES, stream) != hipSuccess) return;
    Args a{};
    a.x = (const float*)d_in[0]; a.c = (const float*)d_in[1]; a.w_ada = (const float*)d_in[2]; a.b_ada = (const float*)d_in[3]; a.norm1_w = (const float*)d_in[4];
    a.w_in = (const float*)d_in[5]; a.b_forget = (const float*)d_in[6]; a.q_norm_w = (const float*)d_in[7]; a.k_norm_w = (const float*)d_in[8]; a.conv_w = (const float*)d_in[9];
    a.attn_out_norm_w = (const float*)d_in[10]; a.conv_out_norm_w = (const float*)d_in[11]; a.w_out = (const float*)d_in[12]; a.norm2_w = (const float*)d_in[13];
    a.w_router = (const float*)d_in[14]; a.b_router = (const float*)d_in[15]; a.w_gate_up = (const float*)d_in[16]; a.b_gate_up = (const float*)d_in[17];
    a.w_down = (const float*)d_in[18]; a.b_down = (const float*)d_in[19];
    a.out = (float*)d_out; a.ws = (unsigned char*)d_ws;
    hipLaunchKernelGGL(fwd_kernel, dim3(grid), dim3(NTHR), LDS_BYTES, stream, a);
}
```

```cpp
#include <hip/hip_runtime.h>
#include <cstdint>
#include <cstdio>


#define GAS __attribute__((address_space(1)))
#define LAS __attribute__((address_space(3)))
typedef unsigned short bf16;
typedef short bf16x8 __attribute__((ext_vector_type(8)));
typedef float f32x4 __attribute__((ext_vector_type(4)));
typedef float f32x2 __attribute__((ext_vector_type(2)));
typedef unsigned u32x4 __attribute__((ext_vector_type(4)));
typedef unsigned u32x2 __attribute__((ext_vector_type(2)));
typedef __bf16 bf16x2_t __attribute__((ext_vector_type(2)));

constexpr int NB = 8, SEQ = 2048, DM = 1024, T = NB * SEQ;
constexpr int DA = 512, DC = 512, NH = 8, HD = 64;
constexpr int NE = 32, TOPK = 4, DE = 1024;
constexpr int NIN = 3080, NMOD = 6 * DM;
constexpr int COL_F = 1536, COL_GB = 1544, COL_GC = 2056, COL_U = 2568;
constexpr float EPS = 1e-6f, LOG2E = 1.4426950408889634f;
constexpr float C2 = 0.125f * LOG2E;
constexpr int NWAVES = 8, NTHR = 512;
constexpr int ECAP = T;
constexpr int MAXMT = T * TOPK / 256 + NE;

constexpr size_t MiB = 1u << 20;
constexpr size_t WS_CTL = 0, CTL_ZERO_BYTES = 128 * 1024;
constexpr size_t WS_MODP = 1 * MiB;
constexpr size_t WS_LC = 2 * MiB;
constexpr size_t WS_TOT = WS_LC + 512 * 1024;
constexpr size_t WS_MODF = 3 * MiB;
constexpr size_t WS_WFC = 3 * MiB + 512 * 1024;
constexpr size_t WS_WRA = 12 * MiB;
constexpr size_t WS_CSTP = 13 * MiB;
constexpr size_t WS_WIN = 4 * MiB;
constexpr size_t WS_WOUT = 10 * MiB;
constexpr size_t WS_WGU = 16 * MiB;
constexpr size_t WS_WD = 144 * MiB;
constexpr size_t WS_H = 208 * MiB;
constexpr size_t WS_Q = 240 * MiB, WS_K = 256 * MiB, WS_V = 272 * MiB;
constexpr size_t WS_GB = 288 * MiB, WS_CU = 304 * MiB;
constexpr size_t WS_MIX = 320 * MiB;
constexpr size_t WS_TOKSLOT = 352 * MiB;
constexpr size_t WS_ROWTOK = 353 * MiB;
constexpr size_t WS_ROWW = 356 * MiB;
constexpr size_t WS_ACT = 360 * MiB;
constexpr size_t WS_Y = 504 * MiB;
constexpr size_t WS_O = 648 * MiB;
constexpr size_t WS_END = 664 * MiB;
constexpr int CW_BAR = 4096;
constexpr int CW_CNT = 16384;

constexpr int LDS_BYTES = 163840;
constexpr int MISC_OFF = LDS_BYTES - 512;

#define LDS_WAIT() asm volatile("s_waitcnt lgkmcnt(0)" ::: "memory")
#define VM_WAIT() asm volatile("s_waitcnt vmcnt(0)" ::: "memory")

__device__ __forceinline__ unsigned cvtpk(float lo, float hi) { f32x2 v = {lo, hi}; bf16x2_t b = __builtin_convertvector(v, bf16x2_t); return __builtin_bit_cast(unsigned, b); }
__device__ __forceinline__ float bf_lo(unsigned w) { return __uint_as_float(w << 16); }
__device__ __forceinline__ float bf_hi(unsigned w) { return __uint_as_float(w & 0xffff0000u); }

#define XB_TMO      128
#define XB_XCNT(j)  (256  + 64 * (j))
#define XB_XSUB(j)  (1280 + 64 * (j))
#define XB_XGEN(j)  (2304 + 64 * (j))
#define XB_TOP      3328
#define XB_TOPGEN   3392
#define XCD_BAR_WORDS 3456
#define XB_SPIN_CAP (1u << 18)

__device__ __forceinline__ unsigned xb_ld(unsigned* p)              { return __hip_atomic_load(p, __ATOMIC_RELAXED, __HIP_MEMORY_SCOPE_AGENT); }
__device__ __forceinline__ unsigned xb_add(unsigned* p, unsigned v) { return __hip_atomic_fetch_add(p, v, __ATOMIC_RELAXED, __HIP_MEMORY_SCOPE_AGENT); }
__device__ __forceinline__ unsigned xb_xcc_id() { return (unsigned)__builtin_amdgcn_s_getreg((3 << 11) | 20) & 0xFu; }
#define XB_SPIN(cond, bar) do { unsigned _sp = 0; while (cond) { __builtin_amdgcn_s_sleep(1); \
    if ((++_sp & 255u) == 0u) { if (xb_ld(&(bar)[XB_TMO])) break; if (_sp > XB_SPIN_CAP) { atomicAdd(&(bar)[XB_TMO], 1u); break; } } } } while (0)

struct XcdBarrier { unsigned* bar; unsigned x; volatile LAS unsigned* st; };

__device__ __forceinline__ XcdBarrier xcd_barrier_post(unsigned* bar, volatile LAS unsigned* st) {
    XcdBarrier b; b.bar = bar; b.x = xb_xcc_id(); b.st = st;
    if (threadIdx.x == 0) (void)xb_add(&bar[XB_XCNT(b.x)], 1u);
    return b;
}
__device__ __forceinline__ void xcd_barrier_complete(unsigned* bar, unsigned x, unsigned& nloc, unsigned& nx) {
    const unsigned G = gridDim.x * gridDim.y * gridDim.z;
    unsigned sum, cnt, mine, sp = 0u;
    for (;;) {
        sum = 0u; cnt = 0u; mine = 0u;
#pragma unroll
        for (unsigned j = 0; j < 16; ++j) { const unsigned c = xb_ld(&bar[XB_XCNT(j)]); sum += c; cnt += (c > 0u) ? 1u : 0u; mine = (j == x) ? c : mine; }
        if (sum == G) break;
        __builtin_amdgcn_s_sleep(1);
        if ((++sp & 255u) == 0u) { if (xb_ld(&bar[XB_TMO])) break; if (sp > XB_SPIN_CAP) { atomicAdd(&bar[XB_TMO], 1u); break; } }
    }
    nloc = mine > 0u ? mine : 1u; nx = cnt > 0u ? cnt : 1u;
}
__device__ __forceinline__ void xcd_barrier(const XcdBarrier& b) {
    asm volatile("s_waitcnt vmcnt(0)" ::: "memory");
    __syncthreads();
    if (threadIdx.x == 0) {
        unsigned* bar = b.bar;
        __builtin_amdgcn_s_waitcnt(0);
        unsigned nloc = b.st[0], nx = b.st[1];
        if (nloc == 0u) { xcd_barrier_complete(bar, b.x, nloc, nx); b.st[0] = nloc; b.st[1] = nx; }
        const unsigned old = xb_add(&bar[XB_XSUB(b.x)], 1u);
        const unsigned gen = old / nloc;
        if (old + 1u == (gen + 1u) * nloc) {
            __builtin_amdgcn_fence(__ATOMIC_RELEASE, "agent");
            asm volatile("s_waitcnt vmcnt(0)" ::: "memory");
            const unsigned og = xb_add(&bar[XB_TOP], 1u);
            const unsigned tg = og / nx;
            if (og + 1u == (tg + 1u) * nx) xb_add(&bar[XB_TOPGEN], 1u);
            else XB_SPIN(xb_ld(&bar[XB_TOPGEN]) == tg, bar);
            __builtin_amdgcn_fence(__ATOMIC_ACQUIRE, "agent");
            xb_add(&bar[XB_XGEN(b.x)], 1u);
            asm volatile("s_waitcnt vmcnt(0)" ::: "memory");
        } else {
            XB_SPIN(xb_ld(&bar[XB_XGEN(b.x)]) == gen, bar);
            __builtin_amdgcn_fence(__ATOMIC_ACQUIRE, "agent");
            asm volatile("s_waitcnt vmcnt(0)" ::: "memory");
        }
    }
    __syncthreads();
}

__device__ __forceinline__ void store16_wt(void* p, u32x4 v) { asm volatile("global_store_dwordx4 %0, %1, off sc1\n\ts_nop 1" :: "v"(p), "v"(v) : "memory"); }
__device__ __forceinline__ int opaque_tid() { int t = threadIdx.x; asm volatile("" : "+v"(t)); return t; }
__device__ __forceinline__ float wave_sum(float v) {
#pragma unroll
    for (int o = 1; o < 64; o <<= 1) v += __shfl_xor(v, o);
    return v;
}
__device__ __forceinline__ float siluf(float v) { return v / (1.f + __expf(-v)); }

struct Args {
    const float* x; const float* c; const float* w_ada; const float* b_ada; const float* norm1_w; const float* w_in; const float* b_forget;
    const float* q_norm_w; const float* k_norm_w; const float* conv_w; const float* attn_out_norm_w; const float* conv_out_norm_w; const float* w_out;
    const float* norm2_w; const float* w_router; const float* b_router; const float* w_gate_up; const float* b_gate_up; const float* w_down; const float* b_down;
    float* out; unsigned char* ws;
};

struct TItem { const float* src; bf16* dst; int ldw, K; };
__device__ __forceinline__ void titem_load(const TItem& t, int lane, f32x4 (&v)[8]) {
#pragma unroll
    for (int i = 0; i < 8; ++i) v[i] = __builtin_nontemporal_load((const f32x4*)(t.src + (size_t)(16 * (i >> 1) + 2 * (lane >> 3) + (i & 1)) * t.ldw + 4 * (lane & 7)));
}
__device__ __forceinline__ void titem_store(const TItem& t, int lane, const f32x4 (&v)[8], LAS unsigned* scr) {
#pragma unroll
    for (int ip = 0; ip < 4; ++ip) { const int kp = 8 * ip + (lane >> 3);
#pragma unroll
        for (int j = 0; j < 4; ++j) scr[(4 * (lane & 7) + j) * 33 + kp] = cvtpk(v[2 * ip][j], v[2 * ip + 1][j]); }
    LDS_WAIT(); asm volatile("" ::: "memory");
#pragma unroll
    for (int p = 0; p < 4; ++p) { const int n = (lane >> 3) + 8 * p, c = lane & 7; const LAS unsigned* s = scr + n * 33 + 4 * c;
        u32x4 o; o.x = s[0]; o.y = s[1]; o.z = s[2]; o.w = s[3];
        *(u32x4*)(t.dst + (size_t)n * t.K + 8 * c) = o; }
    LDS_WAIT(); asm volatile("" ::: "memory");
}

constexpr float YSCALE = 32.f;
constexpr float WSCALE = 64.f;
typedef int v8i __attribute__((ext_vector_type(8)));
__device__ __forceinline__ unsigned pack4_fp8(float a, float b, float c, float d) { unsigned w = __builtin_amdgcn_cvt_pk_fp8_f32(a, b, 0u, false); return __builtin_amdgcn_cvt_pk_fp8_f32(c, d, w, true); }
struct TItem8 { const float* src; unsigned char* dst; int ldw, K; };
__device__ __forceinline__ void titem8_load(const TItem8& t, int lane, f32x4 (&v)[16]) {
#pragma unroll
    for (int i = 0; i < 16; ++i) v[i] = __builtin_nontemporal_load((const f32x4*)(t.src + (size_t)(32 * (i >> 2) + 4 * (lane >> 3) + (i & 3)) * t.ldw + 4 * (lane & 7)));
}
__device__ __forceinline__ void titem8_store(const TItem8& t, int lane, const f32x4 (&v)[16], LAS unsigned* scr) {
#pragma unroll
    for (int q = 0; q < 4; ++q) { const int kq = 8 * q + (lane >> 3);
#pragma unroll
        for (int j = 0; j < 4; ++j) scr[(4 * (lane & 7) + j) * 33 + kq] = pack4_fp8(v[4 * q][j] * WSCALE, v[4 * q + 1][j] * WSCALE, v[4 * q + 2][j] * WSCALE, v[4 * q + 3][j] * WSCALE); }
    LDS_WAIT(); asm volatile("" ::: "memory");
#pragma unroll
    for (int p = 0; p < 4; ++p) { const int n = (lane >> 3) + 8 * p, c = lane & 7; const LAS unsigned* s = scr + n * 33 + 4 * c;
        u32x4 o; o.x = s[0]; o.y = s[1]; o.z = s[2]; o.w = s[3];
        __builtin_nontemporal_store(o, (u32x4*)(t.dst + (size_t)n * t.K + 16 * c)); }
    LDS_WAIT(); asm volatile("" ::: "memory");
}

__device__ __forceinline__ int win_src_col(int g) {
    const int pn = g >> 3, p0 = (g & 7) * 32, bj = p0 >> 7, wc = (p0 >> 5) & 3;
    if (pn < 2) return 256 * pn + 64 * wc + 32 * bj;
    if (pn < 4) return 512 + 256 * (pn - 2) + 64 * wc + 32 * bj;
    if (pn < 6) return 1024 + 256 * (pn - 4) + p0;
    if (pn < 8) return COL_GB + 256 * (pn - 6) + p0;
    return (bj ? COL_U : COL_GC) + 128 * (pn - 8) + 32 * wc;
}

namespace pg8 {
constexpr int BM = 256, BK = 64, HALF = 128, HTB = HALF * BK * 2, STAGE_BYTES = 8 * HTB;
__device__ __forceinline__ int lds_byte(int r, int c) { const int st = (r >> 4) * 2 + (c >> 5), rr = r & 15, cc = c & 31, ob = rr * 64 + cc * 2; return st * 1024 + (ob ^ (((ob >> 9) & 1) << 5)); }
__device__ __forceinline__ void stage_rc(int b, int& R, int& C) { const int st = b / 1024, sb = b % 1024, swz = sb ^ (((sb >> 9) & 1) << 5); R = (st >> 1) * 16 + swz / 64; C = (st & 1) * 32 + (swz % 64) / 2; }
__device__ __forceinline__ int perm32(int rho) { const int n = rho >> 4, i = rho & 15; return 8 * (i >> 2) + 4 * n + (i & 3); }
}
struct Unit { int pm, pn; };

template <class Epi, class Sched, bool ALIGN_EPI>
__device__ __forceinline__ void gemm_phase(LAS unsigned char* lds, const bf16* A, const bf16* Bt, const int K, const Sched& S, const Epi& E) {
    using namespace pg8;
    const int tid = opaque_tid(), wid = __builtin_amdgcn_readfirstlane(tid >> 6), lane = tid & 63, wr = wid >> 2, wc = wid & 3, fr = lane & 15, fq = lane >> 4;
    const int nt = K / BK;
    int Ra[2]; unsigned Ca2[2], voffB[2];
#pragma unroll
    for (int i = 0; i < 2; ++i) { int R, C; stage_rc(tid * 16 + i * 8192, R, C); const int Rb = (R & ~31) + perm32(R & 31); Ra[i] = R; Ca2[i] = (unsigned)C * 2u; voffB[i] = (unsigned)(Rb * K + C) * 2u; }
    const size_t kstep = (size_t)(BK * 2), hstep = (size_t)HALF * K * 2, tstep = 2 * hstep;
    const unsigned ldsw = (unsigned)wid * 1024u;
    LAS unsigned char* ldsA = lds + lds_byte(wr * 64 + fr, fq * 8); LAS unsigned char* ldsB = lds + 4 * HTB + lds_byte(wc * 32 + fr, fq * 8);
    asm volatile("" : "+v"(ldsA)); asm volatile("" : "+v"(ldsB));
#define PG8_SA(b, h) (((b) * 2 + (h)) * HTB)
#define PG8_SB(b, h) ((4 + (b) * 2 + (h)) * HTB)
#define PG8_STAGE_B(bufoff, gbase) do { _Pragma("unroll") for (int _i = 0; _i < 2; ++_i) \
        __builtin_amdgcn_global_load_lds((const unsigned*)((const char*)(gbase) + voffB[_i]), (LAS unsigned*)(lds + (bufoff) + ldsw + _i * 8192), 16, 0, 0); } while (0)
#define PG8_STAGE_A(bufoff, kbytes, off, h) do { _Pragma("unroll") for (int _i = 0; _i < 2; ++_i) \
        __builtin_amdgcn_global_load_lds((const unsigned*)((const char*)A + (kbytes) + off[h][_i]), (LAS unsigned*)(lds + (bufoff) + ldsw + _i * 8192), 16, 0, 0); } while (0)
#define PG8_LDA(dst, b, h) do { _Pragma("unroll") for (int m = 0; m < 4; ++m) _Pragma("unroll") for (int k = 0; k < 2; ++k) dst[m][k] = *(const LAS bf16x8*)(ldsA + PG8_SA(b, h) + m * 2048 + k * 1024); } while (0)
#define PG8_LDB(dst, b, h) do { _Pragma("unroll") for (int n = 0; n < 2; ++n) _Pragma("unroll") for (int k = 0; k < 2; ++k) dst[n][k] = *(const LAS bf16x8*)(ldsB + PG8_SA(b, h) + n * 2048 + k * 1024); } while (0)
#define PG8_MMA(ai, bj, At, Bt_) do { __builtin_amdgcn_s_setprio(1); _Pragma("unroll") for (int m = 0; m < 4; ++m) _Pragma("unroll") for (int n = 0; n < 2; ++n) _Pragma("unroll") for (int k = 0; k < 2; ++k) \
        acc[ai][bj][m][n] = __builtin_amdgcn_mfma_f32_16x16x32_bf16(Bt_[n][k], At[m][k], acc[ai][bj][m][n], 0, 0, 0); __builtin_amdgcn_s_setprio(0); } while (0)
#define PG8_WAIT_V(n) asm volatile("s_waitcnt vmcnt(" #n ")" ::: "memory")
#define PG8_WAIT_L(n) asm volatile("s_waitcnt lgkmcnt(" #n ")" ::: "memory")
#define PG8_BAR __builtin_amdgcn_s_barrier()
#define PG8_SCHED __builtin_amdgcn_sched_barrier(0)
    Unit cur, nxt; int ui = 0;
    if (!S.next(0, cur)) return;
    f32x4 acc[2][2][4][2];
#pragma unroll
    for (int a = 0; a < 2; ++a)
#pragma unroll
        for (int b = 0; b < 2; ++b)
#pragma unroll
            for (int m = 0; m < 4; ++m)
#pragma unroll
                for (int n = 0; n < 2; ++n) acc[a][b][m][n] = (f32x4){0.f, 0.f, 0.f, 0.f};
    bf16x8 At[4][2], B0[2][2], B1[2][2];
    LAS float* epi = (LAS float*)(lds + 136192 + wid * 768);
    unsigned coff[2][2], noff[2][2];
#pragma unroll
    for (int h = 0; h < 2; ++h)
#pragma unroll
        for (int i = 0; i < 2; ++i) coff[h][i] = S.a_off(0, cur, HALF * h + Ra[i]) + Ca2[i];
    const char* cB = (const char*)Bt + (size_t)cur.pn * tstep;
    PG8_STAGE_B(PG8_SB(0, 0), cB); PG8_STAGE_B(PG8_SB(0, 1), cB + hstep); PG8_STAGE_A(PG8_SA(0, 0), 0, coff, 0); PG8_STAGE_A(PG8_SA(0, 1), 0, coff, 1);
    if (wr == 1) PG8_BAR;
    PG8_WAIT_V(2); PG8_BAR;
    PG8_STAGE_B(PG8_SB(1, 0), cB + kstep); PG8_STAGE_A(PG8_SA(1, 0), kstep, coff, 0); PG8_STAGE_B(PG8_SB(1, 1), cB + hstep + kstep);
    PG8_WAIT_V(6); PG8_BAR;
    for (;;) {
        const bool has_next = S.next(ui + 1, nxt);
#pragma unroll
        for (int h = 0; h < 2; ++h)
#pragma unroll
            for (int i = 0; i < 2; ++i) noff[h][i] = has_next ? (S.a_off(ui + 1, nxt, HALF * h + Ra[i]) + Ca2[i]) : coff[h][i];
        const char* nB = has_next ? (const char*)Bt + (size_t)nxt.pn * tstep : cB;
#pragma unroll 1
        for (int t = 0; t < nt; t += 2) {
            const bool last = (t == nt - 2);
            const size_t k1 = (size_t)(t + 1) * kstep;
            const size_t k2 = last ? 0 : (size_t)(t + 2) * kstep, k3 = k2 + kstep;
            const char* b2 = last ? nB : cB + (size_t)(t + 2) * kstep; const char* b3 = b2 + kstep;
            unsigned o2[2][2];
#pragma unroll
            for (int h = 0; h < 2; ++h)
#pragma unroll
                for (int i = 0; i < 2; ++i) o2[h][i] = last ? noff[h][i] : coff[h][i];
            if (last) E.prefetch(cur, wr, wc, lane, epi);
            PG8_LDB(B0, 0, 0); PG8_LDB(B1, 0, 1); PG8_SCHED; PG8_LDA(At, 0, 0); PG8_STAGE_A(PG8_SA(1, 1), k1, coff, 1);
            PG8_WAIT_V(8); PG8_WAIT_L(0); PG8_BAR; PG8_MMA(0, 0, At, B0); PG8_MMA(0, 1, At, B1); PG8_BAR; PG8_SCHED;
            PG8_LDA(At, 0, 1); PG8_STAGE_B(PG8_SB(0, 0), b2); PG8_STAGE_B(PG8_SB(0, 1), b2 + hstep); PG8_STAGE_A(PG8_SA(0, 0), k2, o2, 0);
            PG8_WAIT_V(8); PG8_WAIT_L(0); PG8_BAR; PG8_MMA(1, 0, At, B0); PG8_MMA(1, 1, At, B1); PG8_BAR; PG8_SCHED;
            PG8_LDB(B0, 1, 0); PG8_LDB(B1, 1, 1); PG8_SCHED; PG8_LDA(At, 1, 0); PG8_STAGE_A(PG8_SA(0, 1), k2, o2, 1);
            PG8_WAIT_V(8); PG8_WAIT_L(0); PG8_BAR; PG8_MMA(0, 0, At, B0); PG8_MMA(0, 1, At, B1); PG8_BAR; PG8_SCHED;
            PG8_LDA(At, 1, 1); PG8_STAGE_B(PG8_SB(1, 0), b3); PG8_STAGE_B(PG8_SB(1, 1), b3 + hstep); PG8_STAGE_A(PG8_SA(1, 0), k3, o2, 0);
            PG8_WAIT_V(8); PG8_WAIT_L(0); PG8_BAR; PG8_MMA(1, 0, At, B0); PG8_MMA(1, 1, At, B1); PG8_BAR; PG8_SCHED;
        }
        if constexpr (ALIGN_EPI) { if (wr == 0) PG8_BAR; }
        E(acc, cur, wr, wc, fr, fq, (const LAS float*)epi);
        if (!has_next) break;
#pragma unroll
        for (int a = 0; a < 2; ++a)
#pragma unroll
            for (int b = 0; b < 2; ++b)
#pragma unroll
                for (int m = 0; m < 4; ++m)
#pragma unroll
                    for (int n = 0; n < 2; ++n) acc[a][b][m][n] = (f32x4){0.f, 0.f, 0.f, 0.f};
        cur = nxt; cB = nB; ++ui;
#pragma unroll
        for (int h = 0; h < 2; ++h)
#pragma unroll
            for (int i = 0; i < 2; ++i) coff[h][i] = noff[h][i];
        if constexpr (ALIGN_EPI) { if (wr == 1) PG8_BAR; }
    }
    PG8_WAIT_V(0);
    if constexpr (!ALIGN_EPI) { if (wr == 0) PG8_BAR; }
    PG8_BAR;
#undef PG8_SA
#undef PG8_SB
#undef PG8_STAGE_A
#undef PG8_STAGE_B
#undef PG8_LDA
#undef PG8_LDB
#undef PG8_MMA
#undef PG8_WAIT_V
#undef PG8_WAIT_L
#undef PG8_BAR
#undef PG8_SCHED
}

constexpr int BGD_STASH = 142336;
struct BgDown {
    const float* wd; unsigned char* wd8; int gw; bool on;
    __device__ __forceinline__ bool active(int ui) const { return on && ui < 8; }
    __device__ __forceinline__ void load(int ui, int lane, f32x4 (&v)[8]) const {
        const int h = gw * 8 + ui, r = h >> 1, e = r >> 8, g = (r >> 3) & 31, kb = r & 7;
        const float* src = wd + (size_t)e * DE * DM + (size_t)(128 * kb + 64 * (h & 1) + 8 * (lane >> 3)) * DM + 32 * g + 4 * (lane & 7);
#pragma unroll
        for (int i = 0; i < 8; ++i) asm volatile("global_load_dwordx4 %0, %1, off nt" : "=v"(v[i]) : "v"(src + (size_t)i * DM) : "memory"); }
    __device__ __forceinline__ void wait(f32x4 (&v)[8]) const {
        asm volatile("s_waitcnt vmcnt(8)" : "+v"(v[0]), "+v"(v[1]), "+v"(v[2]), "+v"(v[3]), "+v"(v[4]), "+v"(v[5]), "+v"(v[6]), "+v"(v[7]) :: "memory"); }
    __device__ __forceinline__ void park(int lane, const f32x4 (&v)[8], LAS unsigned char* st) const {
#pragma unroll
        for (int j = 0; j < 4; ++j) { u32x2 o; o.x = pack4_fp8(v[0][j] * WSCALE, v[1][j] * WSCALE, v[2][j] * WSCALE, v[3][j] * WSCALE); o.y = pack4_fp8(v[4][j] * WSCALE, v[5][j] * WSCALE, v[6][j] * WSCALE, v[7][j] * WSCALE);
            *(LAS u32x2*)(st + (4 * (lane & 7) + j) * 64 + 8 * (lane >> 3)) = o; } }
    __device__ __forceinline__ void flush(int ui, int lane, const LAS unsigned char* st) const {
        const int h = gw * 8 + ui, r = h >> 1, e = r >> 8, g = (r >> 3) & 31, kb = r & 7; unsigned char* dst = wd8 + ((size_t)e * DM + 32 * g) * DE + 128 * kb + 64 * (h & 1);
#pragma unroll
        for (int m = 0; m < 2; ++m) { const int p_ = lane + 64 * m; const u32x4 o = *(const LAS u32x4*)(st + 16 * p_); *(u32x4*)(dst + (size_t)(p_ >> 2) * DE + 16 * (p_ & 3)) = o; } }
};
struct BgNone { __device__ __forceinline__ bool active(int) const { return false; } __device__ __forceinline__ void load(int, int, f32x4 (&)[8]) const {} __device__ __forceinline__ void wait(f32x4 (&)[8]) const {}
    __device__ __forceinline__ void park(int, const f32x4 (&)[8], LAS unsigned char*) const {} __device__ __forceinline__ void flush(int, int, const LAS unsigned char*) const {} };
template <class Epi, class Sched, bool ALIGN_EPI, class Bg>
__device__ __forceinline__ void gemm_phase_f8(LAS unsigned char* lds, const unsigned char* A, const unsigned char* Bt, const int K, const Sched& S, const Epi& E, const Bg& BGW) {
    using namespace pg8;
    const int tid = opaque_tid(), wid = __builtin_amdgcn_readfirstlane(tid >> 6), lane = tid & 63, wr = wid >> 2, wc = wid & 3, fr = lane & 15, fq = lane >> 4;
    const int nt = K / 128;
    const __amdgpu_buffer_rsrc_t rsA = __builtin_amdgcn_make_buffer_rsrc((void*)A, 0, 0x7fffffff, 0x00020000), rsB = __builtin_amdgcn_make_buffer_rsrc((void*)Bt, 0, 0x7fffffff, 0x00020000);
    int Ra[2]; unsigned Ca2[2], voffB[2];
#pragma unroll
    for (int i = 0; i < 2; ++i) { const int p = wid + 8 * i, r16 = 8 * (p & 1) + (lane >> 3), R = 16 * (p >> 1) + r16, C = 16 * ((lane & 7) ^ ((r16 >> 1) & 7)); const int Rb = (R & ~31) + perm32(R & 31); Ra[i] = R; Ca2[i] = (unsigned)C; voffB[i] = (unsigned)(Rb * K + C); }
    const unsigned kstep = 128, hstep = (unsigned)HALF * K, tstep = 2 * hstep;
    const unsigned ldsw = (unsigned)wid * 1024u;
    const int fro = (fr >> 3) * 1024 + (fr & 7) * 128 + 16 * (fq ^ ((fr >> 1) & 7));
    LAS unsigned char* ldsA = lds + wr * 8192 + fro; LAS unsigned char* ldsB = lds + 4 * HTB + wc * 4096 + fro;
    LAS unsigned char* ldsAh = lds + wr * 8192 + (fro ^ 64); LAS unsigned char* ldsBh = lds + 4 * HTB + wc * 4096 + (fro ^ 64);
    asm volatile("" : "+v"(ldsA)); asm volatile("" : "+v"(ldsB)); asm volatile("" : "+v"(ldsAh)); asm volatile("" : "+v"(ldsBh));
#define PG8_SA(b, h) (((b) * 2 + (h)) * HTB)
#define PG8_SB(b, h) ((4 + (b) * 2 + (h)) * HTB)
#define PG8_STAGE_B(bufoff, soff) do { _Pragma("unroll") for (int _i = 0; _i < 2; ++_i) \
        __builtin_amdgcn_raw_ptr_buffer_load_lds(rsB, (LAS unsigned*)(lds + (bufoff) + ldsw + _i * 8192), 16, voffB[_i], (soff), 0, 0); } while (0)
#define PG8_STAGE_A(bufoff, soff, h) do { _Pragma("unroll") for (int _i = 0; _i < 2; ++_i) \
        __builtin_amdgcn_raw_ptr_buffer_load_lds(rsA, (LAS unsigned*)(lds + (bufoff) + ldsw + _i * 8192), 16, coff[h][_i], (soff), 0, 0); } while (0)
#define PG8_LD32(dst, ptr, ptrh) do { const u32x4 lo_ = *(const LAS u32x4*)(ptr), hi_ = *(const LAS u32x4*)(ptrh); dst = (v8i){(int)lo_.x, (int)lo_.y, (int)lo_.z, (int)lo_.w, (int)hi_.x, (int)hi_.y, (int)hi_.z, (int)hi_.w}; } while (0)
#define PG8_LDA(dst, b, h) do { _Pragma("unroll") for (int m = 0; m < 4; ++m) PG8_LD32(dst[m], ldsA + PG8_SA(b, h) + m * 2048, ldsAh + PG8_SA(b, h) + m * 2048); } while (0)
#define PG8_LDB(dst, b, h) do { _Pragma("unroll") for (int n = 0; n < 2; ++n) PG8_LD32(dst[n], ldsB + PG8_SA(b, h) + n * 2048, ldsBh + PG8_SA(b, h) + n * 2048); } while (0)
#define PG8_MMA(ai, bj, At, Bt_) do { __builtin_amdgcn_s_setprio(1); _Pragma("unroll") for (int m = 0; m < 4; ++m) _Pragma("unroll") for (int n = 0; n < 2; ++n) \
        acc[ai][bj][m][n] = __builtin_amdgcn_mfma_scale_f32_16x16x128_f8f6f4(Bt_[n], At[m], acc[ai][bj][m][n], 0, 0, 0, 0, 0, 0); __builtin_amdgcn_s_setprio(0); } while (0)
#define PG8_WAIT_V(n) asm volatile("s_waitcnt vmcnt(" #n ")" ::: "memory")
#define PG8_WAIT_L(n) asm volatile("s_waitcnt lgkmcnt(" #n ")" ::: "memory")
#define PG8_BAR __builtin_amdgcn_s_barrier()
#define PG8_SCHED __builtin_amdgcn_sched_barrier(0)
    Unit cur, nxt; int ui = 0;
    if (!S.next(0, cur)) return;
    f32x4 acc[2][2][4][2];
#pragma unroll
    for (int a = 0; a < 2; ++a)
#pragma unroll
        for (int b = 0; b < 2; ++b)
#pragma unroll
            for (int m = 0; m < 4; ++m)
#pragma unroll
                for (int n = 0; n < 2; ++n) acc[a][b][m][n] = (f32x4){0.f, 0.f, 0.f, 0.f};
    v8i At[4], B0[2], B1[2];
    LAS float* epi = (LAS float*)(lds + 136192 + wid * 768);
    unsigned coff[2][2];
#pragma unroll
    for (int h = 0; h < 2; ++h)
#pragma unroll
        for (int i = 0; i < 2; ++i) coff[h][i] = S.a_off(0, cur, HALF * h + Ra[i]) + Ca2[i];
    unsigned cB = (unsigned)cur.pn * tstep;
    PG8_STAGE_B(PG8_SB(0, 0), cB); PG8_STAGE_B(PG8_SB(0, 1), cB + hstep); PG8_STAGE_A(PG8_SA(0, 0), 0u, 0); PG8_STAGE_A(PG8_SA(0, 1), 0u, 1);
    if (wr == 1) PG8_BAR;
    PG8_WAIT_V(2); PG8_BAR;
    PG8_STAGE_B(PG8_SB(1, 0), cB + kstep); PG8_STAGE_A(PG8_SA(1, 0), kstep, 0); PG8_STAGE_B(PG8_SB(1, 1), cB + hstep + kstep);
    PG8_WAIT_V(6); PG8_BAR;
    for (;;) {
        const bool has_next = S.next(ui + 1, nxt);
        const unsigned nB = has_next ? (unsigned)nxt.pn * tstep : cB;
#pragma unroll 1
        for (int t = 0; t < nt; t += 2) {
            const bool last = (t == nt - 2);
            const unsigned k1 = (unsigned)(t + 1) * kstep;
            const unsigned k2 = last ? 0u : (unsigned)(t + 2) * kstep, k3 = k2 + kstep;
            const unsigned b2 = last ? nB : cB + (unsigned)(t + 2) * kstep, b3 = b2 + kstep;
            if (last) E.prefetch(cur, wr, wc, lane, epi);
            PG8_LDB(B0, 0, 0); PG8_LDB(B1, 0, 1); PG8_SCHED; PG8_LDA(At, 0, 0); PG8_STAGE_A(PG8_SA(1, 1), k1, 1);
            if (last && has_next) {
#pragma unroll
                for (int h = 0; h < 2; ++h)
#pragma unroll
                    for (int i = 0; i < 2; ++i) coff[h][i] = S.a_off(ui + 1, nxt, HALF * h + Ra[i]) + Ca2[i];
            }
            PG8_WAIT_V(8); PG8_WAIT_L(0); PG8_BAR; PG8_MMA(0, 0, At, B0); PG8_MMA(0, 1, At, B1); PG8_BAR; PG8_SCHED;
            PG8_LDA(At, 0, 1); PG8_STAGE_B(PG8_SB(0, 0), b2); PG8_STAGE_B(PG8_SB(0, 1), b2 + hstep); PG8_STAGE_A(PG8_SA(0, 0), k2, 0);
            PG8_WAIT_V(8); PG8_WAIT_L(0); PG8_BAR; PG8_MMA(1, 0, At, B0); PG8_MMA(1, 1, At, B1); PG8_BAR; PG8_SCHED;
            PG8_LDB(B0, 1, 0); PG8_LDB(B1, 1, 1); PG8_SCHED; PG8_LDA(At, 1, 0); PG8_STAGE_A(PG8_SA(0, 1), k2, 1);
            PG8_WAIT_V(8); PG8_WAIT_L(0); PG8_BAR; PG8_MMA(0, 0, At, B0); PG8_MMA(0, 1, At, B1); PG8_BAR; PG8_SCHED;
            PG8_LDA(At, 1, 1); PG8_STAGE_B(PG8_SB(1, 0), b3); PG8_STAGE_B(PG8_SB(1, 1), b3 + hstep); PG8_STAGE_A(PG8_SA(1, 0), k3, 0);
            PG8_WAIT_V(8); PG8_WAIT_L(0); PG8_BAR; PG8_MMA(1, 0, At, B0); PG8_MMA(1, 1, At, B1); PG8_BAR; PG8_SCHED;
        }
        if constexpr (ALIGN_EPI) { if (wr == 0) PG8_BAR; }
        if (ui > 0 && BGW.active(ui - 1)) BGW.flush(ui - 1, lane, lds + BGD_STASH + wid * 2048);
        if (BGW.active(ui)) { f32x4 bgv[8]; BGW.load(ui, lane, bgv); PG8_SCHED; E(acc, cur, wr, wc, fr, fq, (const LAS float*)epi); PG8_SCHED; BGW.wait(bgv); BGW.park(lane, bgv, lds + BGD_STASH + wid * 2048); }
        else E(acc, cur, wr, wc, fr, fq, (const LAS float*)epi);
        if (!has_next) break;
#pragma unroll
        for (int a = 0; a < 2; ++a)
#pragma unroll
            for (int b = 0; b < 2; ++b)
#pragma unroll
                for (int m = 0; m < 4; ++m)
#pragma unroll
                    for (int n = 0; n < 2; ++n) acc[a][b][m][n] = (f32x4){0.f, 0.f, 0.f, 0.f};
        cur = nxt; cB = nB; ++ui;
        if constexpr (ALIGN_EPI) { if (wr == 1) PG8_BAR; }
    }
    if (BGW.active(ui)) BGW.flush(ui, lane, lds + BGD_STASH + wid * 2048);
    PG8_WAIT_V(0);
    if constexpr (!ALIGN_EPI) { if (wr == 0) PG8_BAR; }
    PG8_BAR;
#undef PG8_SA
#undef PG8_SB
#undef PG8_STAGE_A
#undef PG8_STAGE_B
#undef PG8_LD32
#undef PG8_LDA
#undef PG8_LDB
#undef PG8_MMA
#undef PG8_WAIT_V
#undef PG8_WAIT_L
#undef PG8_BAR
#undef PG8_SCHED
}

struct StaticOrder {
    int nM, nN, nwg, G, c, K;
    __device__ __forceinline__ void init(int M, int N, int K_, int G_, int c_) { nM = M / 256; nN = N / 256; nwg = nM * nN; G = G_; c = c_; K = K_; }
    __device__ __forceinline__ bool next(int i, Unit& u) const {
        const long L = (long)i * G + c; if (L >= nwg) return false;
        int wgid = (int)L; { const int q = nwg / 8, r = nwg % 8, xcd = wgid % 8, off = wgid / 8; wgid = (xcd < r ? xcd * (q + 1) : r * (q + 1) + (xcd - r) * q) + off; }
        const int nig = 8 * nN, gid = wgid / nig, fm = gid * 8, gsz = (nM - fm) < 8 ? (nM - fm) : 8;
        u.pm = fm + ((wgid % nig) % gsz); u.pn = (wgid % nig) / gsz; return true;
    }
    __device__ __forceinline__ unsigned a_off(int, const Unit& u, int r) const { return (unsigned)((u.pm * 256 + r) * K) * 2u; }
};
template <bool GATHER> struct MoeOrder {
    int NPN, start, end, per, slot, K  ; const LAS int* tile_e; const LAS unsigned short* tokl;
    __device__ __forceinline__ void init(int MT, int NPN_, int K_, int G, int c, const LAS int* tile_e_, const LAS unsigned short* tokl_) {
        NPN = NPN_; K = K_; tile_e = tile_e_; tokl = tokl_;
        const int U = MT * NPN, nx = (G % 8 == 0) ? 8 : 1; per = G / nx; const int x = c % nx; slot = c / nx;
        const int q = U / nx, r = U % nx; start = (x < r) ? x * (q + 1) : r * (q + 1) + (x - r) * q; end = start + ((x < r) ? q + 1 : q);
    }
    __device__ __forceinline__ bool next(int i, Unit& u) const { const int L = start + i * per + slot; if (L >= end) return false; const int mt = L / NPN, pn = L - mt * NPN; u.pm = mt; u.pn = tile_e[mt] * NPN + pn; return true; }
    __device__ __forceinline__ unsigned a_off(int ui, const Unit& u, int r) const { const unsigned row = GATHER ? (unsigned)tokl[ui * 256 + r] : (unsigned)(u.pm * 256 + r); return row * (unsigned)K; }
};

__device__ __forceinline__ u32x4 lane_tr4(u32x4 v, int lane) { const int src = ((((lane & 3) << 4) | (lane >> 2))) << 2;
    u32x4 o; o.x = (unsigned)__builtin_amdgcn_ds_bpermute(src, (int)v.x); o.y = (unsigned)__builtin_amdgcn_ds_bpermute(src, (int)v.y); o.z = (unsigned)__builtin_amdgcn_ds_bpermute(src, (int)v.z); o.w = (unsigned)__builtin_amdgcn_ds_bpermute(src, (int)v.w); return o; }
__device__ __forceinline__ u32x2 lane_tr2(u32x2 v, int lane) { const int src = ((((lane & 3) << 4) | (lane >> 2))) << 2;
    u32x2 o; o.x = (unsigned)__builtin_amdgcn_ds_bpermute(src, (int)v.x); o.y = (unsigned)__builtin_amdgcn_ds_bpermute(src, (int)v.y); return o; }
struct EpiInProj {
    bf16 *Q, *Kb, *V, *GB, *CU; const float* qw; const float* kw;
    __device__ __forceinline__ void prefetch(const Unit& u, int wr, int wc, int lane, LAS float* scr) const {
        __builtin_amdgcn_global_load_lds((const unsigned*)(((u.pn < 2) ? qw : kw) + lane), (LAS unsigned*)scr, 4, 0, 0); }
    __device__ __forceinline__ void operator()(const f32x4 (&acc)[2][2][4][2], const Unit& u, int wr, int wc, int fr, int fq, const LAS float* scr) const {
        const int lane = fr + 16 * fq, frt = lane >> 2, fqt = lane & 3;
        const int row0 = u.pm * 256 + wr * 64 + fr, row0t = u.pm * 256 + wr * 64 + frt, pn = u.pn; (void)row0;
        if (pn < 4) {
            const float sc = (pn < 2) ? C2 : 1.f; bf16* O = (pn < 2) ? Q : Kb;
            float w[2][2][4];
#pragma unroll
            for (int bj = 0; bj < 2; ++bj)
#pragma unroll
                for (int n = 0; n < 2; ++n) { const f32x4 t4 = *(const LAS f32x4*)(scr + 32 * bj + 8 * fq + 4 * n);
#pragma unroll
                    for (int i = 0; i < 4; ++i) w[bj][n][i] = t4[i] * sc; }
#pragma unroll
            for (int ai = 0; ai < 2; ++ai)
#pragma unroll
                for (int m = 0; m < 4; ++m) {
                    float ss = 0.f;
#pragma unroll
                    for (int bj = 0; bj < 2; ++bj)
#pragma unroll
                        for (int n = 0; n < 2; ++n) { const f32x4 v = acc[ai][bj][m][n]; ss += (v[0] * v[0] + v[1] * v[1]) + (v[2] * v[2] + v[3] * v[3]); }
                    ss += __shfl_xor(ss, 16); ss += __shfl_xor(ss, 32);
                    const float rstd = rsqrtf(ss * (1.f / 64.f) + EPS);
                    bf16* rowp = O + (size_t)(row0t + ai * 128 + m * 16) * DA + 256 * (pn & 1) + 64 * wc + 8 * fqt;
#pragma unroll
                    for (int bj = 0; bj < 2; ++bj) { const f32x4 v0 = acc[ai][bj][m][0], v1 = acc[ai][bj][m][1]; u32x4 o;
                        o.x = cvtpk(v0[0] * rstd * w[bj][0][0], v0[1] * rstd * w[bj][0][1]); o.y = cvtpk(v0[2] * rstd * w[bj][0][2], v0[3] * rstd * w[bj][0][3]);
                        o.z = cvtpk(v1[0] * rstd * w[bj][1][0], v1[1] * rstd * w[bj][1][1]); o.w = cvtpk(v1[2] * rstd * w[bj][1][2], v1[3] * rstd * w[bj][1][3]);
                        *(u32x4*)(rowp + 32 * bj) = lane_tr4(o, lane); }
                }
        } else if (pn < 8) {
            bf16* O = (pn < 6) ? V : GB; const int ct = 256 * (pn & 1);
#pragma unroll
            for (int ai = 0; ai < 2; ++ai)
#pragma unroll
                for (int m = 0; m < 4; ++m) { bf16* rowp = O + (size_t)(row0t + ai * 128 + m * 16) * DA + ct + 32 * wc + 8 * fqt;
#pragma unroll
                    for (int bj = 0; bj < 2; ++bj) { const f32x4 v0 = acc[ai][bj][m][0], v1 = acc[ai][bj][m][1]; u32x4 o;
                        o.x = cvtpk(v0[0], v0[1]); o.y = cvtpk(v0[2], v0[3]); o.z = cvtpk(v1[0], v1[1]); o.w = cvtpk(v1[2], v1[3]);
                        *(u32x4*)(rowp + 128 * bj) = lane_tr4(o, lane); } }
        } else {
            const int ct = 128 * (pn - 8);
#pragma unroll
            for (int ai = 0; ai < 2; ++ai)
#pragma unroll
                for (int m = 0; m < 4; ++m) { bf16* rowp = CU + (size_t)(row0t + ai * 128 + m * 16) * DC + ct + 32 * wc + 8 * fqt;
                    const f32x4 v0 = acc[ai][0][m][0] * acc[ai][1][m][0], v1 = acc[ai][0][m][1] * acc[ai][1][m][1]; u32x4 o;
                    o.x = cvtpk(v0[0], v0[1]); o.y = cvtpk(v0[2], v0[3]); o.z = cvtpk(v1[0], v1[1]); o.w = cvtpk(v1[2], v1[3]);
                    *(u32x4*)rowp = lane_tr4(o, lane); }
        }
    }
};
struct EpiOutProj {
    bf16* D; const float* modf;
    __device__ __forceinline__ void prefetch(const Unit& u, int wr, int wc, int lane, LAS float* scr) const {
        const int b = (u.pm * 256) / SEQ, c0 = u.pn * 256 + 32 * wc;
        __builtin_amdgcn_global_load_lds((const unsigned*)(modf + (size_t)b * NMOD + 2 * DM + ((lane < 32) ? c0 + lane : c0 + 128 + lane - 32)), (LAS unsigned*)scr, 4, 0, 0); }
    __device__ __forceinline__ void operator()(const f32x4 (&acc)[2][2][4][2], const Unit& u, int wr, int wc, int fr, int fq, const LAS float* scr) const {
        const int lane = fr + 16 * fq, row0 = u.pm * 256 + wr * 64 + (lane >> 2), col0 = u.pn * 256 + 32 * wc + 8 * (lane & 3);
        f32x4 g[2][2];
#pragma unroll
        for (int bj = 0; bj < 2; ++bj)
#pragma unroll
            for (int n = 0; n < 2; ++n) g[bj][n] = *(const LAS f32x4*)(scr + 32 * bj + 8 * fq + 4 * n);
#pragma unroll
        for (int ai = 0; ai < 2; ++ai)
#pragma unroll
            for (int m = 0; m < 4; ++m) { bf16* rowp = D + (size_t)(row0 + ai * 128 + m * 16) * DM + col0;
#pragma unroll
                for (int bj = 0; bj < 2; ++bj) { const f32x4 v0 = g[bj][0] * acc[ai][bj][m][0], v1 = g[bj][1] * acc[ai][bj][m][1]; u32x4 o;
                    o.x = cvtpk(v0[0], v0[1]); o.y = cvtpk(v0[2], v0[3]); o.z = cvtpk(v1[0], v1[1]); o.w = cvtpk(v1[2], v1[3]);
                    store16_wt(rowp + 128 * bj, lane_tr4(o, lane)); } }
    }
};
struct EpiGate {
    unsigned char* ACT; const float* bgu_all;
    __device__ __forceinline__ void prefetch(const Unit& u, int wr, int wc, int lane, LAS float* sc) const {
        const int e = u.pn >> 3, c0 = 128 * (u.pn & 7) + 32 * wc; const float* bgu = bgu_all + (size_t)e * 2 * DE;
        __builtin_amdgcn_global_load_lds((const unsigned*)(bgu + ((lane < 32) ? c0 + lane : DE + c0 + lane - 32)), (LAS unsigned*)sc, 4, 0, 0); }
    __device__ __forceinline__ void operator()(const f32x4 (&acc)[2][2][4][2], const Unit& u, int wr, int wc, int fr, int fq, const LAS float* sc) const {
        const int lane = fr + 16 * fq, frt = lane >> 2; const int ch0 = 128 * (u.pn & 7) + 32 * wc + 8 * (lane & 3), slot0 = u.pm * 256;
        f32x4 bg[2], bu[2];
#pragma unroll
        for (int n = 0; n < 2; ++n) { bg[n] = *(const LAS f32x4*)(sc + 8 * fq + 4 * n); bu[n] = *(const LAS f32x4*)(sc + 32 + 8 * fq + 4 * n) + 1.f; }
#pragma unroll
        for (int ai = 0; ai < 2; ++ai)
#pragma unroll
            for (int m = 0; m < 4; ++m) { const int rl = ai * 128 + wr * 64 + m * 16 + frt; float a[8];
#pragma unroll
                for (int n = 0; n < 2; ++n)
#pragma unroll
                    for (int i = 0; i < 4; i += 2) {
                        f32x2 gt = (f32x2){acc[ai][0][m][n][i], acc[ai][0][m][n][i + 1]} * (1.f / WSCALE) + (f32x2){bg[n][i], bg[n][i + 1]};
                        f32x2 up = (f32x2){acc[ai][1][m][n][i], acc[ai][1][m][n][i + 1]} * (1.f / WSCALE) + (f32x2){bu[n][i], bu[n][i + 1]};
                        gt[0] = fminf(gt[0], 7.f); gt[1] = fminf(gt[1], 7.f); up[0] = fminf(fmaxf(up[0], -6.f), 8.f); up[1] = fminf(fmaxf(up[1], -6.f), 8.f);
                        const f32x2 z = gt * (-1.702f * LOG2E);
                        f32x2 e; e[0] = __builtin_amdgcn_exp2f(z[0]); e[1] = __builtin_amdgcn_exp2f(z[1]);
                        e = e + 1.f;
                        f32x2 r; r[0] = __builtin_amdgcn_rcpf(e[0]); r[1] = __builtin_amdgcn_rcpf(e[1]);
                        const f32x2 o2 = (gt * up) * r;
                        a[4 * n + i] = o2[0]; a[4 * n + i + 1] = o2[1]; }
                u32x2 o; o.x = pack4_fp8(a[0], a[1], a[2], a[3]); o.y = pack4_fp8(a[4], a[5], a[6], a[7]);
                *(u32x2*)(ACT + (size_t)(slot0 + rl) * DE + ch0) = lane_tr2(o, lane); }
    }
};
struct EpiDown {
    unsigned char* Y; const float* bd_all; const float* roww_all; const LAS int* ecnt; const LAS int* etile0;
    __device__ __forceinline__ void prefetch(const Unit& u, int wr, int wc, int lane, LAS float* sc) const {
        const int e = u.pn >> 2, c0 = 256 * (u.pn & 3) + 32 * wc, lt = u.pm - etile0[e];
        const float* bd = bd_all + (size_t)e * DM; const float* roww = roww_all + (size_t)e * ECAP + lt * 256 + wr * 64 + lane;
        __builtin_amdgcn_global_load_lds((const unsigned*)(bd + ((lane < 32) ? c0 + lane : c0 + 128 + lane - 32)), (LAS unsigned*)sc, 4, 0, 0);
        __builtin_amdgcn_global_load_lds((const unsigned*)roww, (LAS unsigned*)(sc + 64), 4, 0, 0);
        __builtin_amdgcn_global_load_lds((const unsigned*)(roww + 128), (LAS unsigned*)(sc + 128), 4, 0, 0); }
    __device__ __forceinline__ void operator()(const f32x4 (&acc)[2][2][4][2], const Unit& u, int wr, int wc, int fr, int fq, const LAS float* sc) const {
        const int col0 = 256 * (u.pn & 3) + 32 * wc + 8 * fq, slot0 = u.pm * 256;
        f32x4 bv[2][2];
#pragma unroll
        for (int bj = 0; bj < 2; ++bj)
#pragma unroll
            for (int n = 0; n < 2; ++n) bv[bj][n] = *(const LAS f32x4*)(sc + 32 * bj + 8 * fq + 4 * n);
        const bool odd = (fq & 1) != 0; const int cb = col0 - 8 * (fq & 1);
#pragma unroll
        for (int ai = 0; ai < 2; ++ai)
#pragma unroll
            for (int mp = 0; mp < 2; ++mp) {
                u32x2 pk[2][2];
#pragma unroll
                for (int j = 0; j < 2; ++j) { const int m = 2 * mp + j; const float w = sc[64 + 64 * ai + 16 * m + fr] * YSCALE;
#pragma unroll
                    for (int bj = 0; bj < 2; ++bj) { const f32x4 v0 = (acc[ai][bj][m][0] * (1.f / WSCALE) + bv[bj][0]) * w, v1 = (acc[ai][bj][m][1] * (1.f / WSCALE) + bv[bj][1]) * w;
                        pk[j][bj].x = pack4_fp8(v0[0], v0[1], v0[2], v0[3]); pk[j][bj].y = pack4_fp8(v1[0], v1[1], v1[2], v1[3]); } }
                const int rl = ai * 128 + wr * 64 + (2 * mp + (odd ? 1 : 0)) * 16 + fr;
#pragma unroll
                for (int bj = 0; bj < 2; ++bj) { const u32x2 mine = odd ? pk[1][bj] : pk[0][bj], send = odd ? pk[0][bj] : pk[1][bj]; u32x2 got;
                    got.x = (unsigned)__shfl_xor((int)send.x, 16); got.y = (unsigned)__shfl_xor((int)send.y, 16);
                    u32x4 o; if (odd) { o.x = got.x; o.y = got.y; o.z = mine.x; o.w = mine.y; } else { o.x = mine.x; o.y = mine.y; o.z = got.x; o.w = got.y; }
                    *(u32x4*)(Y + (size_t)(slot0 + rl) * DM + cb + 128 * bj) = o; } }
    }
};


namespace attn_body {
using bf16x8=__attribute__((ext_vector_type(8)))short;
using s16x4=__attribute__((ext_vector_type(4)))short;
using f32x16=__attribute__((ext_vector_type(16)))float;
using u32x4=__attribute__((ext_vector_type(4)))unsigned;
typedef unsigned short bf16;
constexpr int BATCH=NB,NHEAD=NH,D=64,ADM=NHEAD*D;
constexpr int NW=8,QBLK=32,QB=QBLK*NW,KVBLK=64,NQB=SEQ/QB;
__device__ __forceinline__ int crow(int r,int hi){return (r&3)+8*(r>>2)+4*hi;}
#define SBAR() __builtin_amdgcn_sched_barrier(0)
__device__ __forceinline__ void cmask(f32x16&p0,f32x16&p1,int jb,int qrel,int hi){
  const float NEG=-INFINITY; int kb=64*jb+4*hi;
  #pragma unroll
  for(int r=0;r<16;++r){int kv=kb+(r&3)+8*(r>>2); if(kv>qrel)p0[r]=NEG; if(kv+32>qrel)p1[r]=NEG;}
}
constexpr int NSLOT=3, SLOTB=8192;
constexpr int LDS_K=0, LDS_V=NSLOT*SLOTB, LDS_WS=2*NSLOT*SLOTB, LDS_OST=LDS_WS+NW*64*4, LDS_FL=LDS_OST+NW*4096, LDS_BYTES_A=LDS_FL+SEQ*4;
__device__ __forceinline__ void glds16(const void*gsrc,unsigned lds_dst){unsigned keep;
  asm volatile("s_mov_b32 %0, m0\n\ts_mov_b32 m0, %2\n\ts_nop 0\n\tglobal_load_lds_dwordx4 %1, off\n\ts_mov_b32 m0, %0":"=&s"(keep):"v"(gsrc),"s"(lds_dst):"memory");}
struct BgCtx { const float* wgu; unsigned char* wgu8; int gw; int bgc; };
__device__ __forceinline__ void glds16_s(const void*sbase,unsigned voff,unsigned lds_dst){unsigned keep;
  asm volatile("s_mov_b32 %0, m0\n\ts_mov_b32 m0, %3\n\ts_nop 3\n\tglobal_load_lds_dwordx4 %1, %2 nt\n\ts_mov_b32 m0, %0":"=&s"(keep):"v"(voff),"s"(sbase),"s"(lds_dst):"memory");}
__device__ __forceinline__ float max3f(float a,float b,float c){float r;asm("v_max3_f32 %0, %1, %2, %3":"=v"(r):"v"(a),"v"(b),"v"(c));return r;}
__device__ __forceinline__ float max2f(float a,float b){float r;asm("v_max_f32_e32 %0, %1, %2":"=v"(r):"v"(a),"v"(b));return r;}
__device__ __forceinline__ float fadd_s(float a,float b){float r;asm("v_add_f32_e32 %0, %1, %2":"=v"(r):"v"(a),"v"(b));return r;}
__device__ __forceinline__ float fsub_s(float a,float b){float r;asm("v_sub_f32_e32 %0, %1, %2":"=v"(r):"v"(a),"v"(b));return r;}
__device__ __forceinline__ unsigned cvtpk_s(float lo,float hi){f32x2 v={lo,hi};bf16x2_t b=__builtin_convertvector(v,bf16x2_t);return __builtin_bit_cast(unsigned,b);}
#define WAIT_BAR(N) asm volatile("s_waitcnt vmcnt(" #N ") lgkmcnt(0)\n\ts_barrier":::"memory")
typedef __attribute__((address_space(3))) const char* lds_cptr;
typedef short v4i16_t __attribute__((ext_vector_type(4)));
__device__ __forceinline__ void qkt(f32x16&p0,f32x16&p1,const char*Kslot,const bf16x8*qr,int r32,int hi){
  const int s_=(r32>>1)&7, kt=s_>>1; const char*kb=Kslot+r32*128+16*(hi^(s_&1));
  #pragma unroll
  for(int d0=0;d0<4;++d0){
    const bf16x8 b0=*reinterpret_cast<const bf16x8*>(kb+((d0^kt)<<5));
    const bf16x8 b1=*reinterpret_cast<const bf16x8*>(kb+((d0^kt)<<5)+4096);
    p0=__builtin_amdgcn_mfma_f32_32x32x16_bf16(b0,qr[d0],p0,0,0,0);p1=__builtin_amdgcn_mfma_f32_32x32x16_bf16(b1,qr[d0],p1,0,0,0);}
}
__device__ __forceinline__ void kload2(bf16x8*kf,lds_cptr kp,int kt,int j){ const lds_cptr q=kp+((j^kt)<<5); kf[2*j]=*(const __attribute__((address_space(3))) bf16x8*)(q); kf[2*j+1]=*(const __attribute__((address_space(3))) bf16x8*)(q+4096); }
__device__ __forceinline__ void kload8(bf16x8*kf,lds_cptr kp,int kt){ kload2(kf,kp,kt,0); kload2(kf,kp,kt,1); kload2(kf,kp,kt,2); kload2(kf,kp,kt,3); }
__device__ __forceinline__ s16x4 vtr(lds_cptr p){ return __builtin_bit_cast(s16x4,__builtin_amdgcn_ds_read_tr16_b64_v4i16((__attribute__((address_space(3))) v4i16_t*)p)); }
__device__ __forceinline__ float rowmax(const f32x16&p0,const f32x16&p1){
  float a=max3f(p0[0],p0[1],p1[0]),b=max3f(p0[2],p0[3],p1[1]);a=max3f(a,p1[2],p1[3]);
  #pragma unroll
  for(int r=4;r<16;r+=4){a=max3f(a,p0[r],p0[r+1]);b=max3f(b,p0[r+2],p0[r+3]);a=max3f(a,p1[r],p1[r+1]);b=max3f(b,p1[r+2],p1[r+3]);}
  const float m=max2f(a,b);
  auto rr=__builtin_amdgcn_permlane32_swap(__float_as_uint(m),__float_as_uint(m),false,false);
  return max2f(__uint_as_float(rr[0]),__uint_as_float(rr[1]));
}
__device__ __forceinline__ void pv(f32x16*o,int vb,bf16x8 pa0,bf16x8 pa1,bf16x8 pa2,bf16x8 pa3){
  #pragma unroll
  for(int d0=0;d0<2;++d0){s16x4 lo[4],hi[4]; const int vbd=d0?(vb^64):vb;
    #pragma unroll
    for(int ks=0;ks<4;++ks){
      asm volatile("ds_read_b64_tr_b16 %0,%1 offset:%c2":"=&v"(lo[ks]):"v"(vbd),"i"(ks*2048):"memory");
      asm volatile("ds_read_b64_tr_b16 %0,%1 offset:%c2":"=&v"(hi[ks]):"v"(vbd),"i"(ks*2048+1024):"memory");}
    asm volatile("s_waitcnt lgkmcnt(0)":::"memory");SBAR();
    #define PK(k) (bf16x8){lo[k][0],lo[k][1],lo[k][2],lo[k][3],hi[k][0],hi[k][1],hi[k][2],hi[k][3]}
    o[d0]=__builtin_amdgcn_mfma_f32_32x32x16_bf16(pa0,PK(0),o[d0],0,0,0);
    o[d0]=__builtin_amdgcn_mfma_f32_32x32x16_bf16(pa1,PK(1),o[d0],0,0,0);
    o[d0]=__builtin_amdgcn_mfma_f32_32x32x16_bf16(pa2,PK(2),o[d0],0,0,0);
    o[d0]=__builtin_amdgcn_mfma_f32_32x32x16_bf16(pa3,PK(3),o[d0],0,0,0);
    #undef PK
  }
}
typedef __attribute__((address_space(3))) const float* lds_fptr;
#define FLD(key0,g,half) (*(const __attribute__((address_space(3))) f32x4*)(flp+(key0)+32*(half)+8*(g)))
template<int THRL> __device__ __forceinline__ void attn_unit(int b,int h,int qb,const bf16*Q,const bf16*__restrict__ K,const bf16*__restrict__ V,bf16*O,char*shm,BgCtx&bg){
  const int tid=opaque_tid(),lane=tid&63,r32=lane&31,hi=lane>>5; const int wid=__builtin_amdgcn_readfirstlane(tid>>6);
  const long rowbase=(long)b*SEQ; const int q0=qb*QB;
  const bf16*Qw=Q+(rowbase+q0+wid*QBLK)*ADM+h*D;
  const bf16*Kh=K+rowbase*ADM+h*D,*Vh=V+rowbase*ADM+h*D;
  const unsigned lds0=(unsigned)(uintptr_t)shm;
  float*wsf=(float*)(shm+LDS_WS)+wid*64;
  const bf16*ksrc=Kh+(long)(8*wid+(lane>>3))*ADM+8*((lane&7)^(((8*wid+(lane>>3))>>1)&7));
  const bf16*vsrc=Vh+(long)(8*wid+(lane>>3))*ADM+8*((lane&7)^(4*((lane>>4)&1)));
  const unsigned kdst=lds0+LDS_K+wid*1024, vdst=lds0+LDS_V+wid*1024;
  #define DMA_K(t,slot) glds16(ksrc+(long)(t)*KVBLK*ADM,(unsigned)__builtin_amdgcn_readfirstlane(kdst+(slot)))
  #define DMA_V(t,slot) glds16(vsrc+(long)(t)*KVBLK*ADM,(unsigned)__builtin_amdgcn_readfirstlane(vdst+(slot)))
  const int vb0=(int)(lds0+LDS_V)+(4*hi+((lane&15)>>2))*128+64*((lane>>3)&1)+((lane>>4)&1)*32+(lane&3)*8;
  const char*Kbase=shm+LDS_K; bf16x8 kf[8];
  const lds_cptr shm3=(lds_cptr)shm; const int kt=(r32>>2)&3; const lds_cptr kp0=shm3+LDS_K+r32*128+16*(hi^((r32>>1)&1)); const int vo0=(4*hi+((lane&15)>>2))*128+64*((lane>>3)&1)+((lane>>4)&1)*32+(lane&3)*8; const lds_cptr vp0=shm3+LDS_V+vo0; const lds_cptr vp1=shm3+LDS_V+(vo0^64);
  const lds_fptr flp=(lds_fptr)(shm3+LDS_FL)+4*hi;
  const int NT=(q0+QB)/KVBLK;
  DMA_K(0,0);DMA_V(0,0);DMA_K(1,SLOTB);
  bf16x8 qr[4];
  #pragma unroll
  for(int d0=0;d0<4;++d0)qr[d0]=*reinterpret_cast<const bf16x8*>(&Qw[(long)r32*ADM+d0*16+hi*8]);
  float mhat=0.f,l_reg=0.f;f32x16 o[2];o[0]=f32x16{};o[1]=f32x16{};
  const int qrel=wid*QBLK+r32;
  float nm=((lds_fptr)(shm3+LDS_FL))[q0+qrel];
  #define CMASK(P0,P1,t) do{int jb_=(t)-(NT-4); if(jb_>=0)cmask(P0,P1,jb_,qrel,hi);}while(0)
  bool resc=false;
  #define START(P0,P1) do{ const float rm=rowmax(P0,P1); resc=false; \
    { const float dl=rm; mhat=fadd_s(mhat,dl); nm=fsub_s(nm,dl); \
      _Pragma("unroll") for(int r=0;r<16;++r){P0[r]=fsub_s(P0[r],dl);P1[r]=fsub_s(P1[r],dl);} } \
    _Pragma("unroll") for(int r=0;r<16;++r)P0[r]=__builtin_amdgcn_exp2f(P0[r]); }while(0)
  #define RESC() do{ if(resc){ asm volatile("s_waitcnt lgkmcnt(0)":::"memory"); \
      _Pragma("unroll") for(int d_=0;d_<2;++d_) _Pragma("unroll") for(int r=0;r<16;++r)o[d_][r]*=wsf[crow(r,hi)]; } }while(0)
  f32x16 pA0,pA1,pB0,pB1;
  int sl_prev=0,sl_cur=0,sl_next=SLOTB;
  #define ROT() do{sl_prev=sl_cur;sl_cur=sl_next;sl_next=(sl_next==(NSLOT-1)*SLOTB)?0:sl_next+SLOTB;}while(0)
  DMA_K(2,2*SLOTB);
  #pragma unroll
  for(int g=0;g<4;++g){ const f32x4 f0=FLD(0,g,0), f1=FLD(0,g,1);
    #pragma unroll
    for(int j=0;j<4;++j){ pA0[4*g+j]=nm-f0[j]; pA1[4*g+j]=nm-f1[j]; } }
  WAIT_BAR(3);
  qkt(pA0,pA1,Kbase,qr,r32,hi);asm volatile("s_nop 15\n\ts_nop 7":"+v"(pA0),"+v"(pA1));CMASK(pA0,pA1,0);
  START(pA0,pA1);
  _Pragma("unroll") for(int r=0;r<16;++r)pA1[r]=__builtin_amdgcn_exp2f(pA1[r]);
  #pragma unroll
  for(int g=0;g<4;++g){ const f32x4 f0=FLD(64,g,0), f1=FLD(64,g,1);
    #pragma unroll
    for(int j=0;j<4;++j){ pB0[4*g+j]=nm-f0[j]; pB1[4*g+j]=nm-f1[j]; } }
  WAIT_BAR(0);
  DMA_K(3,0);DMA_V(1,SLOTB);
  ROT();
  kload8(kf,kp0+sl_cur,kt);
  WAIT_BAR(2);
  s16x4 vlo[8],vhi[8]; u32x4 pw0,pw1,pw2,pw3;
  #define PKW(P,B) cvtpk_s(P[B],P[B+1])
  #define PAF(k) __builtin_bit_cast(bf16x8,pw##k)
  #define VFR(i) (bf16x8){vlo[i][0],vlo[i][1],vlo[i][2],vlo[i][3],vhi[i][0],vhi[i][1],vhi[i][2],vhi[i][3]}
  #define PIN(x) asm volatile("":"+v"(x))
  #define MX3(a,b,c) __builtin_fmaxf(__builtin_fmaxf((a),(b)),(c))
  #define GAPA(MF,A0,A1,A2,A3,W0,W1,PW) do{ MF; sacc+=A0; sacc+=A1; sacc+=A2; sacc+=A3; PIN(sacc); W0; W1; PIN(PW); SBAR(); }while(0)
  #define EX(v) __builtin_amdgcn_exp2f(v)
    \
  #define GAPB(MF,X,B,GF,NX,G,HALF,key0n) do{ MF; X[B]=EX(X[B]); X[B+1]=EX(X[B+1]); X[B+2]=EX(X[B+2]); X[B+3]=EX(X[B+3]); PIN(X); \
      if(GF){ const f32x4 f_=FLD(key0n,G,HALF); NX[4*(G)]=nm-f_[0]; NX[4*(G)+1]=nm-f_[1]; NX[4*(G)+2]=nm-f_[2]; NX[4*(G)+3]=nm-f_[3]; PIN(NX); } SBAR(); }while(0)
  #define VRD(i) do{ vlo[i]=vtr((((i)>>2)?vq_:vp_)+((i)&3)*2048); vhi[i]=vtr((((i)>>2)?vq_:vp_)+((i)&3)*2048+1024); }while(0)
  #define KRD(G,j) do{ if(G){ kload2(kf,kp0+sl_next,kt,j); SBAR(); } }while(0)
  #define STEP(C0,C1,P0,P1,t,GK,GV,GL) do{ SBAR(); if(GK){DMA_K((t)+3,sl_cur);} if(GV){DMA_V((t)+1,sl_next);} SBAR(); \
    const lds_cptr vp_=vp0+sl_prev, vq_=vp1+sl_prev; const int kn_=64*((t)+1); \
    VRD(0); SBAR(); float sacc=(P0[0]+P0[1]); \
    GAPA(C0=__builtin_amdgcn_mfma_f32_32x32x16_bf16(kf[0],qr[0],C0,0,0,0), P0[2],P0[3],P0[4],P0[5],     pw0[0]=PKW(P0,0), pw0[1]=PKW(P0,2), pw0); \
    VRD(4); SBAR(); GAPA(C1=__builtin_amdgcn_mfma_f32_32x32x16_bf16(kf[1],qr[0],C1,0,0,0), P0[6],P0[7],P0[8],P0[9],     pw0[2]=PKW(P0,4), pw0[3]=PKW(P0,6), pw0); \
    VRD(1); SBAR(); GAPA(C0=__builtin_amdgcn_mfma_f32_32x32x16_bf16(kf[2],qr[1],C0,0,0,0),   P0[10],P0[11],P0[12],P0[13], pw1[0]=PKW(P0,8), pw1[1]=PKW(P0,10), pw1); \
    VRD(5); SBAR(); GAPA(C1=__builtin_amdgcn_mfma_f32_32x32x16_bf16(kf[3],qr[1],C1,0,0,0),   P0[14],P0[15],P1[0],P1[1],   pw1[2]=PKW(P0,12),pw1[3]=PKW(P0,14), pw1); \
    VRD(2); SBAR(); GAPA(C0=__builtin_amdgcn_mfma_f32_32x32x16_bf16(kf[4],qr[2],C0,0,0,0),   P1[2],P1[3],P1[4],P1[5],     pw2[0]=PKW(P1,0), pw2[1]=PKW(P1,2), pw2); \
    VRD(6); SBAR(); GAPA(C1=__builtin_amdgcn_mfma_f32_32x32x16_bf16(kf[5],qr[2],C1,0,0,0),   P1[6],P1[7],P1[8],P1[9],     pw2[2]=PKW(P1,4), pw2[3]=PKW(P1,6), pw2); \
    VRD(3); SBAR(); GAPA(C0=__builtin_amdgcn_mfma_f32_32x32x16_bf16(kf[6],qr[3],C0,0,0,0),   P1[10],P1[11],P1[12],P1[13], pw3[0]=PKW(P1,8), pw3[1]=PKW(P1,10), pw3); \
    VRD(7); SBAR(); GAPA(C1=__builtin_amdgcn_mfma_f32_32x32x16_bf16(kf[7],qr[3],C1,0,0,0),   P1[14],P1[15],0.f,0.f,       pw3[2]=PKW(P1,12),pw3[3]=PKW(P1,14), pw3); \
    l_reg+=sacc; \
    CMASK(C0,C1,t); \
    { float a=MX3(C0[0],C0[1],C1[0]),b=MX3(C0[2],C0[3],C1[1]); a=MX3(a,C1[2],C1[3]); \
      _Pragma("unroll") for(int r=4;r<16;r+=4){a=MX3(a,C0[r],C0[r+1]);b=MX3(b,C0[r+2],C0[r+3]);a=MX3(a,C1[r],C1[r+1]);b=MX3(b,C1[r+2],C1[r+3]);} \
      float rm=__builtin_fmaxf(a,b); { auto rr=__builtin_amdgcn_permlane32_swap(__float_as_uint(rm),__float_as_uint(rm),false,false); rm=__builtin_fmaxf(__uint_as_float(rr[0]),__uint_as_float(rr[1])); } \
      resc=false; \
      if(__builtin_expect(__any(rm>(float)THRL),0)){ const float dl=__builtin_fmaxf(rm,0.f); mhat+=dl; nm-=dl; \
        _Pragma("unroll") for(int r=0;r<16;++r){C0[r]-=dl;C1[r]-=dl;} \
        const float f=__builtin_amdgcn_exp2f(-dl); l_reg*=f; if(hi==0)wsf[r32]=f; resc=true; } } \
    SBAR(); \
    GAPB(o[0]=__builtin_amdgcn_mfma_f32_32x32x16_bf16(PAF(0),VFR(0),o[0],0,0,0), C0,0,  true,P0,0,0,kn_); \
    GAPB(o[1]=__builtin_amdgcn_mfma_f32_32x32x16_bf16(PAF(0),VFR(4),o[1],0,0,0), C0,4,  true,P0,1,0,kn_); \
    KRD(GL,0); GAPB(o[0]=__builtin_amdgcn_mfma_f32_32x32x16_bf16(PAF(1),VFR(1),o[0],0,0,0), C0,8,  true,P0,2,0,kn_); \
    KRD(GL,1); GAPB(o[1]=__builtin_amdgcn_mfma_f32_32x32x16_bf16(PAF(1),VFR(5),o[1],0,0,0), C0,12, true,P0,3,0,kn_); \
    KRD(GL,2); GAPB(o[0]=__builtin_amdgcn_mfma_f32_32x32x16_bf16(PAF(2),VFR(2),o[0],0,0,0), C1,0,  true,P1,0,1,kn_); \
    KRD(GL,3); GAPB(o[1]=__builtin_amdgcn_mfma_f32_32x32x16_bf16(PAF(2),VFR(6),o[1],0,0,0), C1,4,  true,P1,1,1,kn_); \
    GAPB(o[0]=__builtin_amdgcn_mfma_f32_32x32x16_bf16(PAF(3),VFR(3),o[0],0,0,0), C1,8,  true,P1,2,1,kn_); \
    GAPB(o[1]=__builtin_amdgcn_mfma_f32_32x32x16_bf16(PAF(3),VFR(7),o[1],0,0,0), C1,12, true,P1,3,1,kn_); \
    }while(0)
  int t=1;
  #undef CMASK
  #define CMASK(P0,P1,t) do{}while(0)
  #define BG_DECODE() const int c_=(bg.bgc<15)?bg.bgc:15, it_=bg.gw*8+(c_>>1), hh_=c_&1, e_=it_>>9, g_=(it_>>3)&63, kb_=it_&7, pn_=g_>>3, p0_=(g_&7)*32, bj_=p0_>>7, wc_=(p0_>>5)&3
  #define BG_ISSUE() do{ BG_DECODE(); const float*src_=bg.wgu+(size_t)e_*DM*2*DE+(size_t)(128*kb_+64*hh_)*2*DE+(bj_?DE:0)+128*pn_+32*wc_; \
      const int ln_=opaque_tid()&63; const unsigned vo_=(unsigned)(ln_>>3)*(2*DE*4)+(unsigned)(ln_&7)*16u; \
      _Pragma("unroll") for(int i_=0;i_<8;++i_) glds16_s(src_+(size_t)i_*8*2*DE,vo_,(unsigned)__builtin_amdgcn_readfirstlane(lds0+(i_<4?LDS_OST:LDS_BYTES_A)+wid*4096+(i_&3)*1024)); }while(0)
  #define BG_CONSUME(MORE) do{ u32x4 o_[2]; unsigned char*dp_; { BG_DECODE(); const int ln_=opaque_tid()&63, n_=ln_&31, kh_=ln_>>5; \
      const lds_cptr bp_=shm3+(kh_?LDS_BYTES_A:LDS_OST)+wid*4096+n_*4; dp_=bg.wgu8+((size_t)e_*2*DE+32*g_)*DM+128*kb_+64*hh_+(size_t)n_*DM+32*kh_; \
      _Pragma("unroll") for(int hf_=0;hf_<2;++hf_){ float f_[16]; \
        _Pragma("unroll") for(int k_=0;k_<16;++k_) f_[k_]=*(const __attribute__((address_space(3))) float*)(bp_+(16*hf_+k_)*128)*WSCALE; \
        o_[hf_].x=pack4_fp8(f_[0],f_[1],f_[2],f_[3]); o_[hf_].y=pack4_fp8(f_[4],f_[5],f_[6],f_[7]); o_[hf_].z=pack4_fp8(f_[8],f_[9],f_[10],f_[11]); o_[hf_].w=pack4_fp8(f_[12],f_[13],f_[14],f_[15]); } } \
      asm volatile("s_waitcnt lgkmcnt(0)":::"memory"); ++bg.bgc; if(MORE) BG_ISSUE(); \
      *(u32x4*)(dp_)=o_[0]; *(u32x4*)(dp_+16)=o_[1]; }while(0)
  bool bgfirst=true;
  BG_ISSUE();
  for(;t+5<NT;t+=2){
    STEP(pB0,pB1,pA0,pA1,t,true,true,true);     if(bgfirst){WAIT_BAR(10);}else{WAIT_BAR(12);} bgfirst=false; RESC(); ROT();
    STEP(pA0,pA1,pB0,pB1,t+1,true,true,true);   WAIT_BAR(2); RESC(); ROT();
    BG_CONSUME(true);
  }
  #undef CMASK
  #define CMASK(P0,P1,t) do{int jb_=(t)-(NT-4); if(jb_>=0)cmask(P0,P1,jb_,qrel,hi);}while(0)
  #define ENDW(tt) do{ if((tt)+3<NT){WAIT_BAR(2);} else if((tt)+2<NT){WAIT_BAR(1);} else {WAIT_BAR(0);} }while(0)
    \
  #define BGW1(tt) do{ const int n_=((tt)+3<NT)?2:(((tt)+2<NT)?1:0), w_=(bgfirst?8:10)+n_; bgfirst=false; \
      if(w_==12){WAIT_BAR(12);} else if(w_==11){WAIT_BAR(11);} else if(w_==10){WAIT_BAR(10);} else if(w_==9){WAIT_BAR(9);} else {WAIT_BAR(8);} }while(0)
  for(;t+1<NT;t+=2){
    STEP(pB0,pB1,pA0,pA1,t,(t+3<NT),(t+1<NT),(t+1<NT));       BGW1(t);   RESC(); ROT();
    STEP(pA0,pA1,pB0,pB1,t+1,(t+4<NT),(t+2<NT),(t+2<NT));     ENDW(t+1); RESC(); ROT();
    BG_CONSUME(t+3<NT);
  }
  #undef BGW1
  #undef BG_DECODE
  #undef BG_ISSUE
  #undef BG_CONSUME
  STEP(pB0,pB1,pA0,pA1,NT-1,false,false,false); RESC();
  { float sacc=pB0[0]+pB0[1]; _Pragma("unroll") for(int r=2;r<16;++r)sacc+=pB0[r]; _Pragma("unroll") for(int r=0;r<16;++r)sacc+=pB1[r]; l_reg+=sacc;
    pw0=(u32x4){PKW(pB0,0),PKW(pB0,2),PKW(pB0,4),PKW(pB0,6)};pw1=(u32x4){PKW(pB0,8),PKW(pB0,10),PKW(pB0,12),PKW(pB0,14)};pw2=(u32x4){PKW(pB1,0),PKW(pB1,2),PKW(pB1,4),PKW(pB1,6)};pw3=(u32x4){PKW(pB1,8),PKW(pB1,10),PKW(pB1,12),PKW(pB1,14)};
    SBAR(); pv(o,vb0+sl_cur,PAF(0),PAF(1),PAF(2),PAF(3)); }
  #undef PKW
  #undef PAF
  #undef VFR
  #undef PIN
  #undef MX3
  #undef GAPA
  #undef GAPB
  #undef EX
  #undef VRD
  #undef KRD
  #undef STEP
  #undef ENDW
  {auto rr=__builtin_amdgcn_permlane32_swap(__float_as_uint(l_reg),__float_as_uint(l_reg),false,false);l_reg=__uint_as_float(rr[0])+__uint_as_float(rr[1]);}
  if(hi==0)wsf[32+r32]=l_reg;asm volatile("s_waitcnt lgkmcnt(0)":::"memory");
  float rli[16];
  #pragma unroll
  for(int r=0;r<16;++r)rli[r]=__builtin_amdgcn_rcpf(wsf[32+crow(r,hi)]);
  bf16*Ow=O+(rowbase+q0+wid*QBLK)*ADM+h*D;
  { bf16*stg=(bf16*)(shm+LDS_OST)+wid*2048;
    #pragma unroll
    for(int r=0;r<16;++r){const int orow=crow(r,hi);
      #pragma unroll
      for(int d0=0;d0<2;++d0){ const unsigned w=cvtpk_s(o[d0][r]*rli[r],0.f); stg[orow*64+d0*32+r32]=(bf16)(w&0xffffu); } }
    asm volatile("s_waitcnt lgkmcnt(0)":::"memory");
    #pragma unroll
    for(int i=0;i<4;++i){const int row=i*8+(lane>>3),ch=lane&7; const u32x4 v=*(const u32x4*)(stg+row*64+ch*8); *(u32x4*)(Ow+(long)row*ADM+ch*8)=v;} }
  asm volatile("s_waitcnt lgkmcnt(0)\n\ts_barrier":::"memory");
  #undef DMA_K
  #undef DMA_V
  #undef CMASK
  #undef START
  #undef RESC
  #undef ROT
}
#undef FLD
#undef SBAR
#undef WAIT_BAR
}

template <int N> __device__ __forceinline__ int dpp_ror_i(int x) { return __builtin_amdgcn_update_dpp(0, x, 0x120 + N, 0xf, 0xf, false); }
template <int N> __device__ __forceinline__ float dpp_ror_f(float x) { return __builtin_bit_cast(float, __builtin_amdgcn_update_dpp(0, __builtin_bit_cast(int, x), 0x120 + N, 0xf, 0xf, false)); }
template <int N> struct RankStep {
    static __device__ __forceinline__ void run(float v0, float v1, int fr, int& rank0, int& rank1) {
        const float ov0 = dpp_ror_f<N>(v0), ov1 = dpp_ror_f<N>(v1); const bool lower = dpp_ror_i<N>(fr) < fr;
        rank0 += ((ov0 > v0 || (ov0 == v0 && lower)) ? 1 : 0) + ((ov1 > v0) ? 1 : 0);
        rank1 += ((ov0 >= v1) ? 1 : 0) + ((ov1 > v1 || (ov1 == v1 && lower)) ? 1 : 0);
        RankStep<N + 1>::run(v0, v1, fr, rank0, rank1); } };
template <> struct RankStep<16> { static __device__ __forceinline__ void run(float, float, int, int&, int&) {} };
__global__ void __launch_bounds__(NTHR, 2) fwd_kernel(Args A) {
    extern __shared__ __attribute__((aligned(16))) unsigned char lds_raw[];
    LAS unsigned char* lds = (LAS unsigned char*)lds_raw;
    volatile LAS unsigned* MISC = (volatile LAS unsigned*)(lds + MISC_OFF);
    const int tid = threadIdx.x, lane = tid & 63, wave = __builtin_amdgcn_readfirstlane(tid >> 6);
    const int G = gridDim.x, bid = blockIdx.x;
    const int gw = bid * NWAVES + wave, NGW = G * NWAVES;
    unsigned char* ws = A.ws;
    unsigned* ctl = (unsigned*)(ws + WS_CTL);
    float* modf = (float*)(ws + WS_MODF); float* Wfc = (float*)(ws + WS_WFC); unsigned char* WRAg = ws + WS_WRA; float* cstp = (float*)(ws + WS_CSTP);
    float* lcb = (float*)(ws + WS_LC); float* totb = (float*)(ws + WS_TOT);
    bf16* Win_t = (bf16*)(ws + WS_WIN); bf16* Wout_t = (bf16*)(ws + WS_WOUT); unsigned char* Wgu8 = ws + WS_WGU; unsigned char* Wd8 = ws + WS_WD;
    bf16* Hb = (bf16*)(ws + WS_H); bf16* Qb = (bf16*)(ws + WS_Q); bf16* Kb = (bf16*)(ws + WS_K); bf16* Vb = (bf16*)(ws + WS_V); bf16* Ob = (bf16*)(ws + WS_O);
    bf16* GBb = (bf16*)(ws + WS_GB); bf16* CUb = (bf16*)(ws + WS_CU); bf16* MIXb = (bf16*)(ws + WS_MIX); bf16* DELTAb = (bf16*)(ws + WS_GB);
    int* tokslot = (int*)(ws + WS_TOKSLOT); int* rowtok = (int*)(ws + WS_ROWTOK); float* roww = (float*)(ws + WS_ROWW);
    unsigned char* ACT8 = ws + WS_ACT; unsigned char* Y8 = ws + WS_Y; unsigned char* H8 = ws + WS_H;
    unsigned* gcnt = ctl + CW_CNT;

    for (int u = tid; u < 128; u += NTHR) MISC[u] = 0u;
    __syncthreads();
    XcdBarrier bar = xcd_barrier_post(ctl + CW_BAR, MISC + 8);

    {
        const int tid = opaque_tid(), lane = tid & 63, wave = __builtin_amdgcn_readfirstlane(tid >> 6), gw = bid * NWAVES + wave; (void)lane; (void)gw;
        LAS float* silu_tab = (LAS float*)lds;
        if (bid == G - 1) { for (int i = wave * 1024 + lane; i < wave * 1024 + 1024; i += 64) Wfc[i] = A.w_in[(size_t)(i >> 3) * NIN + COL_F + (i & 7)]; }
        float cv[16];
#pragma unroll
        for (int j = 0; j < 16; ++j) cv[j] = (bid < NMOD / 32) ? A.c[tid + NTHR * j] : 0.f;
        constexpr int I_IN0 = 96 * 16, NITEMS0 = I_IN0 + 32 * 16;
        auto decode_bf = [&](int it) -> TItem { int r = it;
            if (r < I_IN0) { const int g = r >> 4, kb = r & 15; return TItem{A.w_in + (size_t)(64 * kb) * NIN + win_src_col(g), Win_t + (size_t)(32 * g) * DM + 64 * kb, NIN, DM}; }
            r -= I_IN0; { const int g = r >> 4, kb = r & 15; return TItem{A.w_out + (size_t)(64 * kb) * DM + 32 * g, Wout_t + (size_t)(32 * g) * DM + 64 * kb, DM, DM}; } };
        const bool has0 = gw < NITEMS0; const TItem ti0 = decode_bf(has0 ? gw : 0); f32x4 va0[8];
        if (has0) titem_load(ti0, lane, va0);
        { LAS float* red = (LAS float*)(lds + 32768 + 8 * 4352 + 2048);
          for (int cg = bid; cg < NMOD / 32; cg += G) {
            const int col = 32 * cg + (lane & 31), kh = lane >> 5;
            float acc[8] = {0.f, 0.f, 0.f, 0.f, 0.f, 0.f, 0.f, 0.f};
            const float* wp = A.w_ada + (size_t)(128 * wave + kh) * NMOD + col;
#define ADA_LD(W, I0) do { _Pragma("unroll") for (int i = 0; i < 16; ++i) W[i] = __builtin_nontemporal_load(wp + (size_t)(2 * ((I0) + i)) * NMOD); } while (0)
#define ADA_FMA(W, I0) do { _Pragma("unroll") for (int i = 0; i < 16; ++i) { const LAS float* sp = silu_tab + (128 * wave + 2 * ((I0) + i) + kh) * 8; const f32x4 s0 = *(const LAS f32x4*)sp, s1 = *(const LAS f32x4*)(sp + 4); \
                    ap[0] += (f32x2){s0[0], s0[1]} * W[i]; ap[1] += (f32x2){s0[2], s0[3]} * W[i]; ap[2] += (f32x2){s1[0], s1[1]} * W[i]; ap[3] += (f32x2){s1[2], s1[3]} * W[i]; } } while (0)
            f32x2 ap[4] = {{0.f, 0.f}, {0.f, 0.f}, {0.f, 0.f}, {0.f, 0.f}};
            float w0[16], w1[16], w2[16], w3[16];
            ADA_LD(w0, 0); ADA_LD(w1, 16); ADA_LD(w2, 32); ADA_LD(w3, 48);
            if (cg == bid && has0) titem_store(ti0, lane, va0, (LAS unsigned*)(lds + 32768 + wave * 4352));
            if (cg == bid) {
#pragma unroll
                for (int j = 0; j < 16; ++j) { const int i = tid + NTHR * j, b = i / DM, k = i % DM; silu_tab[k * 8 + b] = siluf(cv[j]); }
                __syncthreads(); }
            ADA_FMA(w0, 0); ADA_FMA(w1, 16); ADA_FMA(w2, 32); ADA_FMA(w3, 48);
#undef ADA_LD
#undef ADA_FMA
#pragma unroll
            for (int q = 0; q < 4; ++q) { acc[2 * q] = ap[q][0]; acc[2 * q + 1] = ap[q][1]; }
#pragma unroll
            for (int q = 0; q < 8; ++q) acc[q] += __shfl_xor(acc[q], 32);
            if (lane < 32) {
#pragma unroll
                for (int q = 0; q < 8; ++q) red[(wave * 8 + q) * 32 + lane] = acc[q]; }
            __syncthreads();
            if (tid < 256) { const int bb = tid >> 5, c = tid & 31; float sm = A.b_ada[32 * cg + c];
#pragma unroll
                for (int w = 0; w < 8; ++w) sm += red[(w * 8 + bb) * 32 + c];
                modf[(size_t)bb * NMOD + 32 * cg + c] = sm; }
            __syncthreads();
          } }
        { const int tid = opaque_tid(), lane = tid & 63; (void)tid;
        LAS unsigned* scr = (LAS unsigned*)(lds + 32768 + wave * 4352);
        constexpr int I_IN = 96 * 16, I_OUT = 32 * 16, NITEMS = I_IN + I_OUT;
        constexpr int I_GU = NE * 64 * 8, I_D = NE * 32 * 8, NITEMS8 = I_GU + I_D;
        if (has0 && !(bid < NMOD / 32)) titem_store(ti0, lane, va0, scr);
        for (int it = gw + NGW; it < NITEMS; it += NGW) { const TItem ti = decode_bf(it); f32x4 va[8]; titem_load(ti, lane, va); titem_store(ti, lane, va, scr); }
        auto decode8 = [&](int it) -> TItem8 {
            int r = it;
            if (r < I_GU) { const int e = r >> 9, g = (r >> 3) & 63, kb = r & 7; const int pn = g >> 3, p0 = (g & 7) * 32, bj = p0 >> 7, wc = (p0 >> 5) & 3;
                return TItem8{A.w_gate_up + (size_t)e * DM * 2 * DE + (size_t)(128 * kb) * 2 * DE + (bj ? DE : 0) + 128 * pn + 32 * wc, Wgu8 + ((size_t)e * 2 * DE + 32 * g) * DM + 128 * kb, 2 * DE, DM}; }
            r -= I_GU;
            { const int e = r >> 8, g = (r >> 3) & 31, kb = r & 7;
                return TItem8{A.w_down + (size_t)e * DE * DM + (size_t)(128 * kb) * DM + 32 * g, Wd8 + ((size_t)e * DM + 32 * g) * DE + 128 * kb, DM, DE}; }
        };
        if (G != 256) {
#pragma unroll 1
            for (int it = gw; it < NITEMS8; it += NGW) { f32x4 va[16]; const TItem8 ta = decode8(it); titem8_load(ta, lane, va); titem8_store(ta, lane, va, scr); }
        }
        }
    }
    xcd_barrier(bar);

    {
        const int tid = opaque_tid(), lane = tid & 63, wave = __builtin_amdgcn_readfirstlane(tid >> 6), gw = bid * NWAVES + wave; (void)lane; (void)gw;
        LAS float* tabA = (LAS float*)lds; LAS float* tabB = tabA + DM; LAS f32x4* Wf4 = (LAS f32x4*)(tabB + DM)  ; LAS float* lfs = (LAS float*)(Wf4 + 2 * DM)  ;
        for (int rb = bid; rb < T / 64; rb += G) {
            const int b = rb / (SEQ / 64);
            f32x4 tq[8]; f32x4 tsh = {0.f, 0.f, 0.f, 0.f}, tsc = tsh, tnw = tsh;
            if (tid < DM / 4) {
                const int k = 4 * tid; tsh = *(const f32x4*)(modf + (size_t)b * NMOD + k); tsc = *(const f32x4*)(modf + (size_t)b * NMOD + DM + k);
                tnw = *(const f32x4*)(A.norm1_w + k); }
            else { const int k = tid - DM / 4;
#pragma unroll
                for (int q = 0; q < 4; ++q) { const int kk = k + 256 * q; tq[2 * q] = *(const f32x4*)(Wfc + kk * 8); tq[2 * q + 1] = *(const f32x4*)(Wfc + kk * 8 + 4); } }
            const float bfg = A.b_forget[(lane >> 3) & 7];
            asm volatile("" ::: "memory");
            f32x4 v[8][4];
#pragma unroll
            for (int i = 0; i < 8; ++i) { const f32x4* xr = (const f32x4*)(A.x + (size_t)(rb * 64 + wave * 8 + i) * DM) + lane;
#pragma unroll
                for (int j = 0; j < 4; ++j) v[i][j] = __builtin_nontemporal_load(xr + 64 * j); }
            asm volatile("" ::: "memory");
            if (tid < DM / 4) { const int k = 4 * tid;
                *(LAS f32x4*)(tabA + k) = tnw * (1.f + tsc); *(LAS f32x4*)(tabB + k) = tsh; }
            else { const int k = tid - DM / 4;
#pragma unroll
                for (int q = 0; q < 4; ++q) { const int kk = k + 256 * q; const int prow = (kk & ~63) | ((kk & 3) << 4) | ((kk >> 2) & 15); Wf4[prow] = tq[2 * q]; Wf4[DM + prow] = tq[2 * q + 1]; } }
            asm volatile("s_waitcnt lgkmcnt(0)\n\ts_barrier" ::: "memory");
#pragma unroll
            for (int i = 0; i < 8; ++i) {
                const int rl = wave * 8 + i, row = rb * 64 + rl;
                float ss = 0.f;
#pragma unroll
                for (int j = 0; j < 4; ++j) ss += (v[i][j][0] * v[i][j][0] + v[i][j][1] * v[i][j][1]) + (v[i][j][2] * v[i][j][2] + v[i][j][3] * v[i][j][3]);
                const float rstd = rsqrtf(wave_sum(ss) * (1.f / DM) + EPS);
                float fa[8] = {0.f, 0.f, 0.f, 0.f, 0.f, 0.f, 0.f, 0.f};
                u32x2* o8 = (u32x2*)(Hb + (size_t)row * DM) + lane;
#pragma unroll
                for (int j = 0; j < 4; ++j) { const int k4 = lane + 64 * j; const f32x4 a = *(const LAS f32x4*)(tabA + 4 * k4), bb = *(const LAS f32x4*)(tabB + 4 * k4);
                    const f32x4 h = v[i][j] * rstd * a + bb;
                    u32x2 o; o.x = cvtpk(h[0], h[1]); o.y = cvtpk(h[2], h[3]); o8[64 * j] = o;
#pragma unroll
                    for (int c = 0; c < 4; ++c) { const int prow = 256 * j + 64 * (lane >> 4) + 16 * c + (lane & 15); const f32x4 w0 = Wf4[prow], w1 = Wf4[DM + prow];
                        fa[0] += h[c] * w0[0]; fa[1] += h[c] * w0[1]; fa[2] += h[c] * w0[2]; fa[3] += h[c] * w0[3]; fa[4] += h[c] * w1[0]; fa[5] += h[c] * w1[1]; fa[6] += h[c] * w1[2]; fa[7] += h[c] * w1[3]; } }
                { const bool u5 = (lane & 32) != 0, u4 = (lane & 16) != 0, u3 = (lane & 8) != 0;
#pragma unroll
                  for (int q = 0; q < 4; ++q) { const float lo = fa[q], hi = fa[q + 4]; fa[q] = (u5 ? hi : lo) + __shfl_xor(u5 ? lo : hi, 32); }
#pragma unroll
                  for (int q = 0; q < 2; ++q) { const float lo = fa[q], hi = fa[q + 2]; fa[q] = (u4 ? hi : lo) + __shfl_xor(u4 ? lo : hi, 16); }
                  { const float lo = fa[0], hi = fa[1]; fa[0] = (u3 ? hi : lo) + __shfl_xor(u3 ? lo : hi, 8); }
                  fa[0] += __shfl_xor(fa[0], 4); fa[0] += __shfl_xor(fa[0], 2); fa[0] += __shfl_xor(fa[0], 1); }
                if ((lane & 7) == 0) { const float z = fa[0] + bfg; const float ls = (z < 0.f) ? (z - log1pf(__expf(z))) : (-log1pf(__expf(-z))); lfs[rl * 8 + ((lane >> 3) & 7)] = ls * LOG2E; }
            }
            __syncthreads();
            if (wave == 0) {
                const int sb = rb % (SEQ / 64);
#pragma unroll
                for (int j = 0; j < 8; ++j) { float s = lfs[lane * 8 + j];
#pragma unroll
                    for (int o = 1; o < 64; o <<= 1) { const float t = __shfl_up(s, o); if (lane >= o) s += t; }
                    lcb[(size_t)(b * NH + j) * SEQ + sb * 64 + lane] = s; if (lane == 63) totb[(b * NH + j) * 32 + sb] = s; }
            }
            { const int bq = rb >> 5, ks = rb & 31; LAS float* red = lfs + 512;
              if (tid < 256) { const int k = 32 * ks + (tid >> 3), c4 = tid & 7; const int i4 = 4 * DM + k, i3 = 3 * DM + k;
                  const float sc = modf[(size_t)bq * NMOD + i4], sh = modf[(size_t)bq * NMOD + i3];
                  const float a = A.norm2_w[k] * (1.f + sc); const f32x4 w = *(const f32x4*)(A.w_router + (size_t)k * NE + 4 * c4);
                  unsigned char* wp = WRAg + (size_t)bq * 65536 + ((c4 >> 2) * 32 + ks) * 1024 + ((((k >> 3) & 3) * 16 + 4 * (c4 & 3))) * 16 + (k & 7) * 2;
#pragma unroll
                  for (int q = 0; q < 4; ++q) *(unsigned short*)(wp + 16 * q) = (unsigned short)(cvtpk(w[q] * a, 0.f) & 0xffffu);
                  *(LAS f32x4*)(red + 4 * tid) = w * sh; }
              __syncthreads();
              if (tid < 32) { const int c4 = tid >> 2, q = tid & 3; float s = 0.f; for (int t2 = 0; t2 < 32; ++t2) s += red[4 * (8 * t2 + c4) + q]; cstp[((size_t)bq * 32 + ks) * 32 + tid] = s; } }
            __syncthreads();
        }
    }
    xcd_barrier(bar);

    {
        const int tid = opaque_tid(), lane = tid & 63, wave = __builtin_amdgcn_readfirstlane(tid >> 6), gw = bid * NWAVES + wave; (void)lane; (void)gw;
        EpiInProj E{Qb, Kb, Vb, GBb, CUb, A.q_norm_w, A.k_norm_w};
        StaticOrder S; S.init(T, 3072, DM, G, bid);
        gemm_phase<EpiInProj, StaticOrder, true>(lds, Hb, Win_t, DM, S, E);
    }
    float fl_tv = 0.f, fl_lc[4] = {0.f, 0.f, 0.f, 0.f};
    { const int tid = opaque_tid(), lane = tid & 63; const int vcu0 = (G % 8 == 0) ? (bid % 8) * (G / 8) + bid / 8 : bid;
      if (vcu0 < 256) { const int bh = vcu0 >> 2; fl_tv = (lane < 32) ? totb[bh * 32 + lane] : 0.f;
#pragma unroll
          for (int i = 0; i < 4; ++i) fl_lc[i] = lcb[(size_t)bh * SEQ + tid + NTHR * i]; } }
    xcd_barrier(bar);

    {
        const int tid = opaque_tid(), lane = tid & 63, wave = __builtin_amdgcn_readfirstlane(tid >> 6), gw = bid * NWAVES + wave; (void)lane; (void)gw;
        char* shm = (char*)lds_raw;
        LAS float* FL = (LAS float*)(lds + attn_body::LDS_FL);
        const int vcu = (G % 8 == 0) ? (bid % 8) * (G / 8) + bid / 8 : bid;
        for (int v = vcu; v < 256; v += G) {
            const int bh = v >> 2, s = v & 3, b = bh >> 3, h = bh & 7;
            { float pre = 0.f; const float tv = fl_tv; float sc = tv;
#pragma unroll
              for (int o = 1; o < 32; o <<= 1) { const float t2 = __shfl_up(sc, o); if (lane >= o) sc += t2; }
              sc -= tv;
#pragma unroll
              for (int i = 0; i < 4; ++i) { const int t = tid + NTHR * i; pre = __shfl(sc, t >> 6); FL[t] = pre + fl_lc[i]; } }
            VM_WAIT(); __syncthreads();
            attn_body::BgCtx bg{A.w_gate_up, Wgu8, (G == 256) ? gw : 0, (G == 256) ? 0 : 16};
            attn_body::attn_unit<8>(b, h, s, Qb, Kb, Vb, Ob, shm, bg);
            attn_body::attn_unit<8>(b, h, 7 - s, Qb, Kb, Vb, Ob, shm, bg);
            __syncthreads();
            if (v + G < 256) { const int tid2 = opaque_tid(), bh2 = (v + G) >> 2; fl_tv = ((tid2 & 63) < 32) ? totb[bh2 * 32 + (tid2 & 63)] : 0.f;
#pragma unroll
                for (int i = 0; i < 4; ++i) fl_lc[i] = lcb[(size_t)bh2 * SEQ + tid2 + NTHR * i]; }
        }
    }
    xcd_barrier(bar);

    {
        const int tid = opaque_tid(), lane = tid & 63, wave = __builtin_amdgcn_readfirstlane(tid >> 6), gw = bid * NWAVES + wave; (void)lane; (void)gw;
        float cw[3][8], wa[8], wcn[8];
#pragma unroll
        for (int i = 0; i < 8; ++i) { cw[0][i] = A.conv_w[0 * DC + 8 * lane + i]; cw[1][i] = A.conv_w[1 * DC + 8 * lane + i]; cw[2][i] = A.conv_w[2 * DC + 8 * lane + i];
            wa[i] = A.attn_out_norm_w[8 * lane + i]; wcn[i] = A.conv_out_norm_w[8 * lane + i]; }
        for (int rg = gw; rg < T / 8; rg += NGW) {
            const int r0 = rg * 8; const bool head = (r0 % SEQ) == 0;
            u32x4 ow[8], gbw[8], cu[10];
            const u32x4 zero = {0u, 0u, 0u, 0u};
#pragma unroll
            for (int i = 0; i < 8; ++i) { ow[i] = __builtin_nontemporal_load((const u32x4*)(Ob + (size_t)(r0 + i) * DA + 8 * lane)); gbw[i] = __builtin_nontemporal_load((const u32x4*)(GBb + (size_t)(r0 + i) * DC + 8 * lane)); cu[i + 2] = *(const u32x4*)(CUb + (size_t)(r0 + i) * DC + 8 * lane); }
            cu[0] = head ? zero : *(const u32x4*)(CUb + (size_t)(r0 - 2) * DC + 8 * lane); cu[1] = head ? zero : *(const u32x4*)(CUb + (size_t)(r0 - 1) * DC + 8 * lane);
#pragma unroll
            for (int r = 0; r < 8; ++r) {
                float a[8], y[8]; float ssa = 0.f, ssc = 0.f;
#pragma unroll
                for (int i = 0; i < 4; ++i) { const unsigned w_o = ow[r][i], w_g = gbw[r][i], w0 = cu[r + 2][i], w1 = cu[r + 1][i], w2 = cu[r][i];
                    a[2 * i] = bf_lo(w_o); a[2 * i + 1] = bf_hi(w_o);
                    y[2 * i] = bf_lo(w_g) * (cw[0][2 * i] * bf_lo(w2) + cw[1][2 * i] * bf_lo(w1) + cw[2][2 * i] * bf_lo(w0));
                    y[2 * i + 1] = bf_hi(w_g) * (cw[0][2 * i + 1] * bf_hi(w2) + cw[1][2 * i + 1] * bf_hi(w1) + cw[2][2 * i + 1] * bf_hi(w0)); }
#pragma unroll
                for (int i = 0; i < 8; ++i) { ssa += a[i] * a[i]; ssc += y[i] * y[i]; }
                const float ra = rsqrtf(wave_sum(ssa) * (1.f / DA) + EPS), rc = rsqrtf(wave_sum(ssc) * (1.f / DC) + EPS);
                u32x4 oa, oc;
                oa.x = cvtpk(a[0] * ra * wa[0], a[1] * ra * wa[1]); oa.y = cvtpk(a[2] * ra * wa[2], a[3] * ra * wa[3]); oa.z = cvtpk(a[4] * ra * wa[4], a[5] * ra * wa[5]); oa.w = cvtpk(a[6] * ra * wa[6], a[7] * ra * wa[7]);
                oc.x = cvtpk(y[0] * rc * wcn[0], y[1] * rc * wcn[1]); oc.y = cvtpk(y[2] * rc * wcn[2], y[3] * rc * wcn[3]); oc.z = cvtpk(y[4] * rc * wcn[4], y[5] * rc * wcn[5]); oc.w = cvtpk(y[6] * rc * wcn[6], y[7] * rc * wcn[7]);
                store16_wt(MIXb + (size_t)(r0 + r) * DM + 8 * lane, oa); store16_wt(MIXb + (size_t)(r0 + r) * DM + DA + 8 * lane, oc);
            }
        }
    }
    xcd_barrier(bar);

    {
        const int tid = opaque_tid(), lane = tid & 63, wave = __builtin_amdgcn_readfirstlane(tid >> 6), gw = bid * NWAVES + wave; (void)lane; (void)gw;
        EpiOutProj E{DELTAb, modf};
        StaticOrder S; S.init(T, DM, DM, G, bid);
        gemm_phase<EpiOutProj, StaticOrder, false>(lds, MIXb, Wout_t, DM, S, E);
    }
    f32x4 p6_ta = {0.f, 0.f, 0.f, 0.f}, p6_tb = p6_ta; float p6_cs = 0.f;
    { const int tid = opaque_tid(); const int b0 = (bid < T / 64) ? bid / (SEQ / 64) : 0;
      if (tid < DM / 4) { const int k = 4 * tid; p6_ta = *(const f32x4*)(A.norm2_w + k) * (1.f + *(const f32x4*)(modf + (size_t)b0 * NMOD + 4 * DM + k)); p6_tb = *(const f32x4*)(modf + (size_t)b0 * NMOD + 3 * DM + k); }
      if (tid < 32) { float s2 = A.b_router[tid]; for (int t2 = 0; t2 < 32; ++t2) s2 += cstp[((size_t)b0 * 32 + t2) * 32 + tid]; p6_cs = s2; } }
    xcd_barrier(bar);

    {
        const int tid = opaque_tid(), lane = tid & 63, wave = __builtin_amdgcn_readfirstlane(tid >> 6), gw = bid * NWAVES + wave; (void)lane; (void)gw;
        LAS unsigned char* WRA = lds; LAS unsigned char* XT = lds + 65536;
        LAS float* tabA = (LAS float*)(lds + 131072); LAS float* tabB = tabA + DM;
        LAS float* cst = tabB + DM  ; LAS float* rstdv = cst + 32  ;
        LAS int* lcnt = (LAS int*)(rstdv + 64); LAS int* lbase = lcnt + 32; LAS int* asg_e = lbase + 32; LAS int* asg_r = asg_e + 256; LAS float* asg_w = (LAS float*)(asg_r + 256);
        for (int rb = bid; rb < T / 64; rb += G) {
            const int tid = opaque_tid(), lane = tid & 63;
            const int b = rb / (SEQ / 64);
            f32x4 ta = p6_ta, tb = p6_tb; float cs = p6_cs;
            if (rb != bid) {
                if (tid < DM / 4) { const int k = 4 * tid; ta = *(const f32x4*)(A.norm2_w + k) * (1.f + *(const f32x4*)(modf + (size_t)b * NMOD + 4 * DM + k)); tb = *(const f32x4*)(modf + (size_t)b * NMOD + 3 * DM + k); }
                if (tid < 32) { float s2 = A.b_router[tid]; for (int t2 = 0; t2 < 32; ++t2) s2 += cstp[((size_t)b * 32 + t2) * 32 + tid]; cs = s2; } }
            __syncthreads();
            if (tid < DM / 4) { const int k = 4 * tid; *(LAS f32x4*)(tabA + k) = ta; *(LAS f32x4*)(tabB + k) = tb; }
            if (tid < 32) { lcnt[tid] = 0; cst[tid] = cs; }
#pragma unroll
            for (int p = 0; p < 8; ++p) __builtin_amdgcn_global_load_lds((const unsigned*)(WRAg + (size_t)b * 65536 + (wave * 8 + p) * 1024 + lane * 16), (LAS unsigned*)(WRA + (wave * 8 + p) * 1024), 16, 0, 0);
            f32x4 v[8][4];
#pragma unroll
            for (int r = 0; r < 8; ++r) { const size_t ro = (size_t)(rb * 64 + wave * 8 + r) * DM; const f32x4* xr = (const f32x4*)(A.x + ro) + lane; const u32x2* dr = (const u32x2*)(DELTAb + ro) + lane;
#pragma unroll
                for (int j = 0; j < 4; ++j) { const f32x4 xv = __builtin_nontemporal_load(xr + 64 * j); const u32x2 dv = dr[64 * j];
                    v[r][j] = xv + (f32x4){bf_lo(dv.x), bf_hi(dv.x), bf_lo(dv.y), bf_hi(dv.y)}; } }
            __syncthreads();
            VM_WAIT();
            float rstd[8];
#pragma unroll
            for (int r = 0; r < 8; ++r) { float ss = 0.f;
#pragma unroll
                for (int j = 0; j < 4; ++j) ss += (v[r][j][0] * v[r][j][0] + v[r][j][1] * v[r][j][1]) + (v[r][j][2] * v[r][j][2] + v[r][j][3] * v[r][j][3]);
                rstd[r] = rsqrtf(wave_sum(ss) * (1.f / DM) + EPS); if (lane == 0) rstdv[wave * 8 + r] = rstd[r]; }
#pragma unroll
            for (int j = 0; j < 4; ++j) { const int k4 = lane + 64 * j; const f32x4 a = *(const LAS f32x4*)(tabA + 4 * k4), bb = *(const LAS f32x4*)(tabB + 4 * k4);
#pragma unroll
                for (int r = 0; r < 8; ++r) { const f32x4 h = v[r][j] * rstd[r] * a + bb; ((unsigned*)(H8 + (size_t)(rb * 64 + wave * 8 + r) * DM))[k4] = pack4_fp8(h[0], h[1], h[2], h[3]);
                    u32x2 xb; xb.x = cvtpk(v[r][j][0], v[r][j][1]); xb.y = cvtpk(v[r][j][2], v[r][j][3]);
                    ((u32x2*)(DELTAb + (size_t)(rb * 64 + wave * 8 + r) * DM))[k4] = xb; } }
            f32x4 acc0 = {0.f, 0.f, 0.f, 0.f}, acc1 = {0.f, 0.f, 0.f, 0.f};
            const int fr = lane & 15, fq = lane >> 4, kh = wave >> 2;
            const int wsp = lane >> 3, wfq = (lane >> 1) & 3, wh8 = lane & 1, wfr0 = 8 * (wave & 1), wc = wfq | ((wsp & 1) ? 12 : 0);
            LAS unsigned char* wbase = XT + (((wave >> 1) * 8 + wsp) * 2) * 1024 + wfq * 256 + 8 * wh8;
            const LAS unsigned char* rbase_e = XT + (wave & 3) * 16384 + fq * 256 + (fr ^ fq) * 16 + kh * 8192;
            const LAS unsigned char* rbase_o = XT + (wave & 3) * 16384 + fq * 256 + (fr ^ (fq | 12)) * 16 + kh * 8192;
            const LAS unsigned char* wrab = WRA + kh * 4096 + lane * 16;
#pragma unroll
            for (int j = 0; j < 4; ++j) {
                __syncthreads();
#pragma unroll
                for (int r = 0; r < 8; ++r) { const f32x4 x = v[r][j];
                    u32x2 hi; hi.x = cvtpk(x[0], x[1]); hi.y = cvtpk(x[2], x[3]);
                    u32x2 lo; lo.x = cvtpk(x[0] - bf_lo(hi.x), x[1] - bf_hi(hi.x)); lo.y = cvtpk(x[2] - bf_lo(hi.y), x[3] - bf_hi(hi.y));
                    LAS unsigned char* p = wbase + ((wfr0 + r) ^ wc) * 16; *(LAS u32x2*)p = hi; *(LAS u32x2*)(p + 1024) = lo; }
                __syncthreads();
#pragma unroll
                for (int ks2 = 0; ks2 < 4; ++ks2) { const LAS unsigned char* ap = ((ks2 & 1) ? rbase_o : rbase_e) + ks2 * 2048;
                    const bf16x8 ahi = *(const LAS bf16x8*)ap, alo = *(const LAS bf16x8*)(ap + 1024);
                    const bf16x8 b0 = *(const LAS bf16x8*)(wrab + (8 * j + ks2) * 1024), b1 = *(const LAS bf16x8*)(wrab + (32 + 8 * j + ks2) * 1024);
                    acc0 = __builtin_amdgcn_mfma_f32_16x16x32_bf16(ahi, b0, acc0, 0, 0, 0); acc0 = __builtin_amdgcn_mfma_f32_16x16x32_bf16(alo, b0, acc0, 0, 0, 0);
                    acc1 = __builtin_amdgcn_mfma_f32_16x16x32_bf16(ahi, b1, acc1, 0, 0, 0); acc1 = __builtin_amdgcn_mfma_f32_16x16x32_bf16(alo, b1, acc1, 0, 0, 0); }
            }
            __syncthreads();
            { LAS f32x4* xs = (LAS f32x4*)XT;
              xs[wave * 64 + lane] = kh ? (f32x4){acc0[0], acc0[1], acc1[0], acc1[1]} : (f32x4){acc0[2], acc0[3], acc1[2], acc1[3]}; }
            __syncthreads();
            {
                const f32x4 po = ((const LAS f32x4*)XT)[(wave ^ 4) * 64 + lane];
                const float a0[2] = {(kh ? acc0[2] : acc0[0]) + po[0], (kh ? acc0[3] : acc0[1]) + po[1]}, a1[2] = {(kh ? acc1[2] : acc1[0]) + po[2], (kh ? acc1[3] : acc1[1]) + po[3]};
                const float c0 = cst[fr], c1 = cst[16 + fr];
#pragma unroll
                for (int rr = 0; rr < 2; ++rr) {
                    const int rl = 16 * (wave & 3) + 4 * fq + 2 * kh + rr; const float rs = rstdv[rl];
                    const float v0 = a0[rr] * rs + c0, v1 = a1[rr] * rs + c1;
                    int rank0 = (v1 > v0) ? 1 : 0, rank1 = (v0 >= v1) ? 1 : 0;
                    RankStep<1>::run(v0, v1, fr, rank0, rank1);
                    const bool sel0 = rank0 < 4, sel1 = rank1 < 4;
                    float m = fmaxf(v0, v1), ps;
                    m = fmaxf(m, dpp_ror_f<8>(m)); m = fmaxf(m, dpp_ror_f<4>(m)); m = fmaxf(m, dpp_ror_f<2>(m)); m = fmaxf(m, dpp_ror_f<1>(m));
                    const float p0 = sel0 ? __expf(v0 - m) : 0.f, p1 = sel1 ? __expf(v1 - m) : 0.f;
                    ps = p0 + p1;
                    ps += dpp_ror_f<8>(ps); ps += dpp_ror_f<4>(ps); ps += dpp_ror_f<2>(ps); ps += dpp_ror_f<1>(ps);
                    const float inv = 1.f / ps;
                    const unsigned g0 = (unsigned)(__ballot(sel0) >> (16 * fq)) & 0xffffu, g1 = (unsigned)(__ballot(sel1) >> (16 * fq)) & 0xffffu;
                    const unsigned below = (1u << fr) - 1u;
                    if (sel0) { const int k = __popc(g0 & below); const int rk = __hip_atomic_fetch_add(lcnt + fr, 1, __ATOMIC_RELAXED, __HIP_MEMORY_SCOPE_WORKGROUP);
                        asg_e[rl * 4 + k] = fr; asg_r[rl * 4 + k] = rk; asg_w[rl * 4 + k] = p0 * inv; }
                    if (sel1) { const int k = __popc(g0) + __popc(g1 & below); const int rk = __hip_atomic_fetch_add(lcnt + 16 + fr, 1, __ATOMIC_RELAXED, __HIP_MEMORY_SCOPE_WORKGROUP);
                        asg_e[rl * 4 + k] = 16 + fr; asg_r[rl * 4 + k] = rk; asg_w[rl * 4 + k] = p1 * inv; }
                }
            }
            __syncthreads();
            if (tid < 32) { const int n = lcnt[tid]; lbase[tid] = n ? (int)__hip_atomic_fetch_add(gcnt + 16 * tid, (unsigned)n, __ATOMIC_RELAXED, __HIP_MEMORY_SCOPE_AGENT) : 0; }
            __syncthreads();
            if (tid < 256) { const int e2 = asg_e[tid], rank = lbase[e2] + asg_r[tid], tok = rb * 64 + (tid >> 2);
                rowtok[(size_t)e2 * ECAP + rank] = tok; roww[(size_t)e2 * ECAP + rank] = asg_w[tid]; tokslot[tok * 4 + (tid & 3)] = (e2 << 16) | rank; }
            __syncthreads();
        }
    }
    xcd_barrier(bar);

    LAS int* ecnt = (LAS int*)(lds + MISC_OFF - 4096); LAS int* etile0 = ecnt + 32; LAS int* tile_e = etile0 + 33;
    if (tid < 64) {
        const int e = tid & 31; const int n = (int)__hip_atomic_load(gcnt + 16 * e, __ATOMIC_RELAXED, __HIP_MEMORY_SCOPE_AGENT); const int nt = (n + 255) >> 8;
        int inc = nt;
#pragma unroll
        for (int o = 1; o < 32; o <<= 1) { const int t2 = __shfl_up(inc, o, 32); if (e >= o) inc += t2; }
        const int base = inc - nt;
        if (tid < 32) { ecnt[e] = n; etile0[e] = base; for (int q = 0; q < nt; ++q) tile_e[base + q] = e; if (e == 31) etile0[NE] = inc; }
    }
    __syncthreads();
    const int MT = etile0[NE];

    {
        const int tid = opaque_tid(), lane = tid & 63, wave = __builtin_amdgcn_readfirstlane(tid >> 6), gw = bid * NWAVES + wave; (void)lane; (void)gw;
        LAS unsigned short* tokl = (LAS unsigned short*)(lds + 131072);
        MoeOrder<true> S; S.init(MT, 8, DM, G, bid, tile_e, tokl);
        { Unit u; int tv[10]; bool ok[10];
#pragma unroll
          for (int i = 0; i < 10; ++i) { ok[i] = S.next(i, u); tv[i] = 0;
              if (ok[i] && tid < 256) { const int e = u.pn >> 3, lt = u.pm - etile0[e], rank = lt * 256 + tid; if (rank < ecnt[e]) tv[i] = rowtok[(size_t)e * ECAP + rank]; } }
#pragma unroll
          for (int i = 0; i < 10; ++i) if (ok[i] && tid < 256) tokl[i * 256 + tid] = (unsigned short)tv[i]; }
        __syncthreads();
        EpiGate E{ACT8, A.b_gate_up};
        BgDown BW{A.w_down, Wd8, gw, G == 256};
        gemm_phase_f8<EpiGate, MoeOrder<true>, true, BgDown>(lds, H8, Wgu8, DM, S, E, BW);
    }
    xcd_barrier(bar);

    {
        const int tid = opaque_tid(), lane = tid & 63, wave = __builtin_amdgcn_readfirstlane(tid >> 6), gw = bid * NWAVES + wave; (void)lane; (void)gw;
        MoeOrder<false> S; S.init(MT, 4, DE, G, bid, tile_e, nullptr);
        EpiDown E{Y8, A.b_down, roww, ecnt, etile0};
        gemm_phase_f8<EpiDown, MoeOrder<false>, true, BgNone>(lds, ACT8, Wd8, DE, S, E, BgNone{});
    }
    xcd_barrier(bar);

    {
        const int tid = opaque_tid(), lane = tid & 63, wave = __builtin_amdgcn_readfirstlane(tid >> 6), gw = bid * NWAVES + wave; (void)lane; (void)gw;
        for (int rg = gw; rg < T / 8; rg += NGW) {
            const int r0 = rg * 8, b = r0 / SEQ;
            int slotv = 0;
            if (lane < 32) { const int ts = tokslot[r0 * 4 + lane]; slotv = etile0[ts >> 16] * 256 + (ts & 0xffff); }
            f32x4 g2v[2][2];
#pragma unroll
            for (int j = 0; j < 2; ++j) { g2v[j][0] = *(const f32x4*)(modf + (size_t)b * NMOD + 5 * DM + 512 * j + 8 * lane) * (1.f / YSCALE); g2v[j][1] = *(const f32x4*)(modf + (size_t)b * NMOD + 5 * DM + 512 * j + 8 * lane + 4) * (1.f / YSCALE); }
#pragma unroll 1
            for (int p = 0; p < 2; ++p) {
                u32x2 yw[4][4][2]; u32x4 xw[4][2];
#pragma unroll
                for (int r = 0; r < 4; ++r) { const int row = r0 + 4 * p + r;
#pragma unroll
                    for (int k = 0; k < 4; ++k) { const int sl = __shfl(slotv, 4 * (4 * p + r) + k);
#pragma unroll
                        for (int j = 0; j < 2; ++j) yw[r][k][j] = __builtin_nontemporal_load((const u32x2*)(Y8 + (size_t)sl * DM + 512 * j + 8 * lane)); }
#pragma unroll
                    for (int j = 0; j < 2; ++j) xw[r][j] = __builtin_nontemporal_load((const u32x4*)(DELTAb + (size_t)row * DM + 512 * j + 8 * lane)); }
#pragma unroll
                for (int r = 0; r < 4; ++r) { const int row = r0 + 4 * p + r;
#pragma unroll
                    for (int j = 0; j < 2; ++j) { float s[8] = {0.f, 0.f, 0.f, 0.f, 0.f, 0.f, 0.f, 0.f};
#pragma unroll
                        for (int k = 0; k < 4; ++k) { const u32x2 w = yw[r][k][j];
                            const f32x2 a0 = __builtin_amdgcn_cvt_pk_f32_fp8((int)w.x, false), a1 = __builtin_amdgcn_cvt_pk_f32_fp8((int)w.x, true), a2 = __builtin_amdgcn_cvt_pk_f32_fp8((int)w.y, false), a3 = __builtin_amdgcn_cvt_pk_f32_fp8((int)w.y, true);
                            s[0] += a0[0]; s[1] += a0[1]; s[2] += a1[0]; s[3] += a1[1]; s[4] += a2[0]; s[5] += a2[1]; s[6] += a3[0]; s[7] += a3[1]; }
                        const u32x4 dv = xw[r][j];
                        const f32x4 x0 = {bf_lo(dv.x), bf_hi(dv.x), bf_lo(dv.y), bf_hi(dv.y)}, x1 = {bf_lo(dv.z), bf_hi(dv.z), bf_lo(dv.w), bf_hi(dv.w)};
                        float* op = A.out + (size_t)row * DM + 512 * j + 8 * lane;
                        __builtin_nontemporal_store(x0 + g2v[j][0] * (f32x4){s[0], s[1], s[2], s[3]}, (f32x4*)op); __builtin_nontemporal_store(x1 + g2v[j][1] * (f32x4){s[4], s[5], s[6], s[7]}, (f32x4*)(op + 4)); } }
            }
        }
    }
}

extern "C" void kernel_launch(void* const* d_in, const int* in_sizes, int n_in, void* d_out, int out_size, void* d_ws, size_t ws_size, hipStream_t stream) {
    static int grid = 0;
    if (grid == 0) {
        if (n_in != 20 || out_size != T * DM || ws_size < WS_END) { fprintf(stderr, "kernel_launch: unexpected problem shape (n_in %d out %d ws %zu)\n", n_in, out_size, ws_size); grid = -1; return; }
        int dev = 0, cus = 0;
        if (hipGetDevice(&dev) != hipSuccess || hipDeviceGetAttribute(&cus, hipDeviceAttributeMultiprocessorCount, dev) != hipSuccess) { grid = -1; return; }
        if (hipFuncSetAttribute((const void*)fwd_kernel, hipFuncAttributeMaxDynamicSharedMemorySize, LDS_BYTES) != hipSuccess) { fprintf(stderr, "kernel_launch: hipFuncSetAttribute failed\n"); grid = -1; return; }
        int per_cu = 0;
        if (hipOccupancyMaxActiveBlocksPerMultiprocessor(&per_cu, (const void*)fwd_kernel, NTHR, LDS_BYTES) != hipSuccess || per_cu < 1) { fprintf(stderr, "kernel_launch: occupancy query says %d\n", per_cu); }
        (void)hipGetLastError();
        grid = cus;
    }
    if (grid < 0) return;
    if (hipMemsetAsync((char*)d_ws + WS_CTL, 0, CTL_ZERO_BYTES, stream) != hipSuccess) return;
    Args a{};
    a.x = (const float*)d_in[0]; a.c = (const float*)d_in[1]; a.w_ada = (const float*)d_in[2]; a.b_ada = (const float*)d_in[3]; a.norm1_w = (const float*)d_in[4];
    a.w_in = (const float*)d_in[5]; a.b_forget = (const float*)d_in[6]; a.q_norm_w = (const float*)d_in[7]; a.k_norm_w = (const float*)d_in[8]; a.conv_w = (const float*)d_in[9];
    a.attn_out_norm_w = (const float*)d_in[10]; a.conv_out_norm_w = (const float*)d_in[11]; a.w_out = (const float*)d_in[12]; a.norm2_w = (const float*)d_in[13];
    a.w_router = (const float*)d_in[14]; a.b_router = (const float*)d_in[15]; a.w_gate_up = (const float*)d_in[16]; a.b_gate_up = (const float*)d_in[17];
    a.w_down = (const float*)d_in[18]; a.b_down = (const float*)d_in[19];
    a.out = (float*)d_out; a.ws = (unsigned char*)d_ws;
    hipLaunchKernelGGL(fwd_kernel, dim3(grid), dim3(NTHR), LDS_BYTES, stream, a);
}
```
